# Optimizing an MI355X kernel written in HIP

```python
import math
import jax
import jax.numpy as jnp
from jax import lax
import numpy as np

D_MODEL = 1024
BATCH = 32
SEQ = 256
DEPTH = 4
DEC_BATCH = 4
DEC_SEQ = 4096
PAST_LEN = 256

GRID_W = 64
N_BRANCH = 3
BRANCH_W = D_MODEL // 2
HY_ORDER = 2
HY_WIDTH = BRANCH_W
HY_POS_BANDS = 16
HY_POS_DIM = 1 + 2 * HY_POS_BANDS
HY_FILT_HIDDEN = 64
HY_DECAY_TARGET = 1e-2
HY_FAST_DECAY = 0.3
HY_SLOW_DECAY = 1.5
NA_HEADS = 8
NA_HEAD_DIM = BRANCH_W // NA_HEADS
NA_WIN_ROWS = 8
NA_WIN_COLS = 16
DA_HEADS = 8
DA_HEAD_DIM = BRANCH_W // (2 * DA_HEADS)
DA_V_DIM = 2 * DA_HEAD_DIM
D_FF = -(-(8 * D_MODEL) // (3 * 256)) * 256
IN_W = 3 * HY_WIDTH + 3 * BRANCH_W + 3 * BRANCH_W + N_BRANCH * D_MODEL
ROPE_BASE = 10000.0
EPS = 1e-6
Q_BLOCK = 128
NEG_INF = -1e30

kernel_name = 'hybrid_diffusion_trunk_step'


def rmsnorm(x, g):
    xf = x.astype(jnp.float32)
    y = xf * lax.rsqrt(jnp.mean(jnp.square(xf), axis=-1, keepdims=True) + EPS)
    return (y * g.astype(jnp.float32)).astype(x.dtype)


def modulated_norm(x, g, shift, scale):
    return rmsnorm(x, g) * (1 + scale[:, None, :]) + shift[:, None, :]


def short_conv(u, w, b):
    up = jnp.pad(u, ((0, 0), (1, 1), (0, 0)))
    return up[:, :-2] * w[0] + up[:, 1:-1] * w[1] + up[:, 2:] * w[2] + b


def hyena_filters(L, w1, b1, w2, b2, w3, freq):
    f32 = jnp.float32
    pos = jnp.arange(L, dtype=f32)
    t = pos / L
    bands = jnp.linspace(1e-4, HY_POS_BANDS - 1, HY_POS_BANDS, dtype=f32)
    ang = (2 * math.pi / L) * pos[:, None] * bands[None, :]
    feats = jnp.concatenate([t[:, None], jnp.cos(ang), -jnp.sin(ang)], axis=-1)
    fr = freq.astype(f32)
    h = jnp.sin(fr * (feats @ w1.astype(f32) + b1.astype(f32)))
    h = jnp.sin(fr * (h @ w2.astype(f32) + b2.astype(f32)))
    h = (h @ w3.astype(f32)).reshape(L, HY_ORDER, 2, HY_WIDTH)
    deltas = jnp.linspace(math.log(HY_DECAY_TARGET) / HY_SLOW_DECAY,
                          math.log(HY_DECAY_TARGET) / HY_FAST_DECAY, HY_WIDTH, dtype=f32)
    decay = jnp.exp(-t[:, None] * jnp.abs(deltas)[None, :])
    h = h * decay[:, None, None, :]
    h_fwd, h_bwd = h[:, :, 0], h[:, :, 1]
    h_full = jnp.concatenate([h_fwd, jnp.zeros((1, HY_ORDER, HY_WIDTH), f32), h_bwd[1:][::-1]], axis=0)
    h_full = h_full / jnp.sum(jnp.abs(h_full), axis=0, keepdims=True)
    return jnp.fft.rfft(h_full, n=2 * L, axis=0)


def long_conv(z, h_freq, bias):
    L = z.shape[1]
    zf = z.astype(jnp.float32)
    y = jnp.fft.irfft(jnp.fft.rfft(zf, n=2 * L, axis=1) * h_freq[None], n=2 * L, axis=1)[:, :L]
    return (y + zf * bias.astype(jnp.float32)).astype(z.dtype)


def hyena_mixer(u, conv_w, conv_b, fw1, fb1, fw2, fb2, fw3, ffreq, fbias):
    L = u.shape[1]
    v, x1, x2 = jnp.split(short_conv(u, conv_w, conv_b), 3, axis=-1)
    hf = hyena_filters(L, fw1, fb1, fw2, fb2, fw3, ffreq)
    z = x1 * long_conv(v, hf[:, 0], fbias[0])
    z = x2 * long_conv(z, hf[:, 1], fbias[1])
    return z


def map_query_blocks(fn, q):
    B, L = q.shape[:2]
    nb = L // Q_BLOCK
    qb = jnp.swapaxes(q, 0, 1).reshape((nb, Q_BLOCK, B) + q.shape[2:])
    out = lax.map(fn, qb)
    out = out.reshape((L, B) + out.shape[3:])
    return jnp.swapaxes(out, 0, 1)


def context_attention(q, k, v):
    B, L, H, dh = q.shape
    scale = dh ** -0.5

    def block(qb):
        s = jnp.einsum('qbhd,bkhd->bhqk', qb, k).astype(jnp.float32) * scale
        p = jax.nn.softmax(s, axis=-1).astype(v.dtype)
        return jnp.einsum('bhqk,bkhd->qbhd', p, v)

    return map_query_blocks(block, q).reshape(B, L, H * dh)


def neighbourhood_attention(q, k, v, k_ctx, v_ctx, rpb):
    B, L, H, dh = q.shape
    rows = L // GRID_W
    wr = min(NA_WIN_ROWS, rows)
    scale = dh ** -0.5
    r = jnp.arange(rows)
    r0 = jnp.clip(r - wr // 2, 0, rows - wr)
    row_idx = r0[:, None] + jnp.arange(wr)[None, :]
    c = jnp.arange(GRID_W)
    c0 = jnp.clip(c - NA_WIN_COLS // 2, 0, GRID_W - NA_WIN_COLS)
    col_ok = (c[None, :] >= c0[:, None]) & (c[None, :] < c0[:, None] + NA_WIN_COLS)
    dr = row_idx - r[:, None]
    dc = jnp.clip(c[None, :] - c[:, None], -(NA_WIN_COLS - 1), NA_WIN_COLS - 1)
    bias = rpb[:, dr[:, None, :, None] + NA_WIN_ROWS - 1, dc[None, :, None, :] + NA_WIN_COLS - 1]
    qg = q.reshape(B, rows, GRID_W, H, dh)
    kg = k.reshape(B, rows, GRID_W, H, dh)[:, row_idx]
    vg = v.reshape(B, rows, GRID_W, H, dh)[:, row_idx]
    s_lat = jnp.einsum('brqhd,brwkhd->bhrqwk', qg, kg).astype(jnp.float32) * scale + bias.astype(jnp.float32)[None]
    s_lat = jnp.where(col_ok[None, None, None, :, None, :], s_lat, NEG_INF)
    s_ctx = jnp.einsum('brqhd,bkhd->bhrqk', qg, k_ctx).astype(jnp.float32) * scale
    n_lat = wr * GRID_W
    s = jnp.concatenate([s_lat.reshape(B, H, rows, GRID_W, n_lat), s_ctx], axis=-1)
    p = jax.nn.softmax(s, axis=-1).astype(v.dtype)
    p_lat = p[..., :n_lat].reshape(B, H, rows, GRID_W, wr, GRID_W)
    p_ctx = p[..., n_lat:]
    o = jnp.einsum('bhrqwk,brwkhd->brqhd', p_lat, vg) + jnp.einsum('bhrqk,bkhd->brqhd', p_ctx, v_ctx)
    return o.reshape(B, L, H * dh)


def axial_rope(x):
    L = x.shape[1]
    f32 = jnp.float32
    pos = jnp.arange(L)
    row = (pos // GRID_W).astype(f32)
    col = (pos % GRID_W).astype(f32)
    n_freq = DA_HEAD_DIM // 4
    inv = ROPE_BASE ** (-jnp.arange(n_freq, dtype=f32) / n_freq)
    ang = jnp.concatenate([row[:, None] * inv[None, :], col[:, None] * inv[None, :]], axis=-1)
    cos = jnp.cos(ang)[None, :, None, None, :]
    sin = jnp.sin(ang)[None, :, None, None, :]
    xp = x.astype(f32).reshape(x.shape[:-1] + (DA_HEAD_DIM // 2, 2))
    x0, x1 = xp[..., 0], xp[..., 1]
    out = jnp.stack([x0 * cos - x1 * sin, x0 * sin + x1 * cos], axis=-1).reshape(x.shape)
    return out.astype(x.dtype)


def diff_attention(q, k, v, lam, lam_init, subln):
    B, L, H = q.shape[:3]
    scale = DA_HEAD_DIM ** -0.5

    def block(qb):
        s = jnp.einsum('qbhid,bkhid->bhiqk', qb, k).astype(jnp.float32) * scale
        p = jax.nn.softmax(s, axis=-1)
        a = (p[:, :, 0] - lam * p[:, :, 1]).astype(v.dtype)
        return jnp.einsum('bhqk,bkhd->qbhd', a, v)

    o = map_query_blocks(block, q)
    o = rmsnorm(o, subln) * (1 - lam_init)
    return o.reshape(B, L, H * DA_V_DIM)


def trunk_layer(x, mod, ctx_cache, lam_init, norm_mix, norm_ffn, w_in, hy_conv_w, hy_conv_b,
                hy_filt_w1, hy_filt_b1, hy_filt_w2, hy_filt_b2, hy_filt_w3, hy_filt_freq, hy_bias,
                na_rpb, da_lambda, da_subln, w_lift, w_out, w_ffn_in, w_ffn_out):
    B, L, _ = x.shape
    shift1, scale1, gate1, shift2, scale2, gate2 = jnp.split(mod, 6, axis=-1)
    h = modulated_norm(x, norm_mix, shift1, scale1)
    u = h @ w_in
    u_hy, u_na, u_da, u_gate = jnp.split(
        u, [3 * HY_WIDTH, 3 * HY_WIDTH + 3 * BRANCH_W, 3 * HY_WIDTH + 6 * BRANCH_W], axis=-1)
    y_hy = hyena_mixer(u_hy, hy_conv_w, hy_conv_b, hy_filt_w1, hy_filt_b1, hy_filt_w2, hy_filt_b2,
                       hy_filt_w3, hy_filt_freq, hy_bias)
    na_q, na_k, na_v = [t.reshape(B, L, NA_HEADS, NA_HEAD_DIM) for t in jnp.split(u_na, 3, axis=-1)]
    da_q, da_k, da_v = jnp.split(u_da, 3, axis=-1)
    da_q = da_q.reshape(B, L, DA_HEADS, 2, DA_HEAD_DIM)
    da_k = da_k.reshape(B, L, DA_HEADS, 2, DA_HEAD_DIM)
    da_v = da_v.reshape(B, L, DA_HEADS, DA_V_DIM)
    lam_p = da_lambda.astype(jnp.float32)
    lam = jnp.exp(jnp.sum(lam_p[0] * lam_p[1])) - jnp.exp(jnp.sum(lam_p[2] * lam_p[3])) + lam_init
    if ctx_cache is None:
        y_na = context_attention(na_q, na_k, na_v)
        y_da = diff_attention(da_q, da_k, da_v, lam, lam_init, da_subln)
        ctx_out = (na_k, na_v, da_k.reshape(B, L, DA_HEADS, 2 * DA_HEAD_DIM), da_v)
    else:
        na_k_ctx, na_v_ctx, da_k_ctx, da_v_ctx = ctx_cache
        Lc = da_k_ctx.shape[1]
        y_na = neighbourhood_attention(na_q, na_k, na_v, na_k_ctx, na_v_ctx, na_rpb)
        k_all = jnp.concatenate([axial_rope(da_k), da_k_ctx.reshape(B, Lc, DA_HEADS, 2, DA_HEAD_DIM)], axis=1)
        v_all = jnp.concatenate([da_v, da_v_ctx], axis=1)
        y_da = diff_attention(axial_rope(da_q), k_all, v_all, lam, lam_init, da_subln)
        ctx_out = None
    g = jax.nn.sigmoid(u_gate).reshape(B, L, N_BRANCH, D_MODEL)
    merged = (g[:, :, 0] * (y_hy @ w_lift[0]) + g[:, :, 1] * (y_na @ w_lift[1])
              + g[:, :, 2] * (y_da @ w_lift[2]))
    x = x + gate1[:, None, :] * (merged @ w_out)
    h2 = modulated_norm(x, norm_ffn, shift2, scale2)
    f_gate, f_up = jnp.split(h2 @ w_ffn_in, 2, axis=-1)
    x = x + gate2[:, None, :] * ((jax.nn.silu(f_gate) * f_up) @ w_ffn_out)
    return x, ctx_out


def setup_inputs(seed: int = 0) -> dict:
    key = jax.random.key(seed)
    ks = jax.random.split(key, 32)

    def nrm(k, shape, scale):
        return jax.random.normal(k, shape, jnp.float32) * scale

    return {
        'x_prompt': nrm(ks[0], (BATCH, SEQ, D_MODEL), 1.0),
        'x_sample': nrm(ks[1], (DEC_BATCH, DEC_SEQ, D_MODEL), 1.0),
        'cache_na_k': nrm(ks[2], (DEC_BATCH, DEPTH, PAST_LEN, NA_HEADS, NA_HEAD_DIM), 1.0),
        'cache_na_v': nrm(ks[3], (DEC_BATCH, DEPTH, PAST_LEN, NA_HEADS, NA_HEAD_DIM), 1.0),
        'cache_da_k': nrm(ks[4], (DEC_BATCH, DEPTH, PAST_LEN, DA_HEADS, 2 * DA_HEAD_DIM), 1.0),
        'cache_da_v': nrm(ks[5], (DEC_BATCH, DEPTH, PAST_LEN, DA_HEADS, DA_V_DIM), 1.0),
        'c': nrm(ks[6], (DEC_BATCH, D_MODEL), 1.0),
        'c_ctx': nrm(ks[7], (D_MODEL,), 0.5),
        'w_ada': nrm(ks[8], (DEPTH, D_MODEL, 6 * D_MODEL), 0.5 * D_MODEL ** -0.5),
        'b_ada': nrm(ks[9], (DEPTH, 6 * D_MODEL), 0.01),
        'norm_mix': 1.0 + nrm(ks[10], (DEPTH, D_MODEL), 0.02),
        'norm_ffn': 1.0 + nrm(ks[11], (DEPTH, D_MODEL), 0.02),
        'w_in': nrm(ks[12], (DEPTH, D_MODEL, IN_W), D_MODEL ** -0.5),
        'hy_conv_w': nrm(ks[13], (DEPTH, 3, 3 * HY_WIDTH), 3 ** -0.5),
        'hy_conv_b': nrm(ks[14], (DEPTH, 3 * HY_WIDTH), 0.02),
        'hy_filt_w1': nrm(ks[15], (DEPTH, HY_POS_DIM, HY_FILT_HIDDEN), HY_POS_DIM ** -0.5),
        'hy_filt_b1': nrm(ks[16], (DEPTH, HY_FILT_HIDDEN), 0.02),
        'hy_filt_w2': nrm(ks[17], (DEPTH, HY_FILT_HIDDEN, HY_FILT_HIDDEN), HY_FILT_HIDDEN ** -0.5),
        'hy_filt_b2': nrm(ks[18], (DEPTH, HY_FILT_HIDDEN), 0.02),
        'hy_filt_w3': nrm(ks[19], (DEPTH, HY_FILT_HIDDEN, HY_ORDER * 2 * HY_WIDTH), HY_FILT_HIDDEN ** -0.5),
        'hy_filt_freq': 1.0 + nrm(ks[20], (DEPTH, HY_FILT_HIDDEN), 0.02),
        'hy_bias': nrm(ks[21], (DEPTH, HY_ORDER, HY_WIDTH), 0.5),
        'na_rpb': nrm(ks[22], (DEPTH, NA_HEADS, 2 * NA_WIN_ROWS - 1, 2 * NA_WIN_COLS - 1), 0.02),
        'da_lambda': nrm(ks[23], (DEPTH, 4, DA_HEAD_DIM), 0.1),
        'da_subln': 1.0 + nrm(ks[24], (DEPTH, DA_V_DIM), 0.02),
        'w_lift': nrm(ks[25], (DEPTH, N_BRANCH, BRANCH_W, D_MODEL), BRANCH_W ** -0.5),
        'w_out': nrm(ks[26], (DEPTH, D_MODEL, D_MODEL), D_MODEL ** -0.5),
        'w_ffn_in': nrm(ks[27], (DEPTH, D_MODEL, 2 * D_FF), D_MODEL ** -0.5),
        'w_ffn_out': nrm(ks[28], (DEPTH, D_FF, D_MODEL), D_FF ** -0.5),
        'norm_final': 1.0 + nrm(ks[29], (D_MODEL,), 0.02),
    }


def reference(x_prompt, x_sample, cache_na_k, cache_na_v, cache_da_k, cache_da_v, c, c_ctx,
              w_ada, b_ada, norm_mix, norm_ffn, w_in, hy_conv_w, hy_conv_b, hy_filt_w1, hy_filt_b1,
              hy_filt_w2, hy_filt_b2, hy_filt_w3, hy_filt_freq, hy_bias, na_rpb, da_lambda, da_subln,
              w_lift, w_out, w_ffn_in, w_ffn_out, norm_final):
    xp = x_prompt
    xs = x_sample
    na_ks, na_vs, da_ks, da_vs = [], [], [], []
    for l in range(DEPTH):
        lam_init = 0.8 - 0.6 * math.exp(-0.3 * l)
        mod_ctx = jax.nn.silu(c_ctx[None, :]) @ w_ada[l] + b_ada[l]
        mod_lat = jax.nn.silu(c) @ w_ada[l] + b_ada[l]
        lp = (norm_mix[l], norm_ffn[l], w_in[l], hy_conv_w[l], hy_conv_b[l], hy_filt_w1[l], hy_filt_b1[l],
              hy_filt_w2[l], hy_filt_b2[l], hy_filt_w3[l], hy_filt_freq[l], hy_bias[l], na_rpb[l],
              da_lambda[l], da_subln[l], w_lift[l], w_out[l], w_ffn_in[l], w_ffn_out[l])
        xp, ctx_kv = trunk_layer(xp, mod_ctx, None, lam_init, *lp)
        na_ks.append(ctx_kv[0])
        na_vs.append(ctx_kv[1])
        da_ks.append(ctx_kv[2])
        da_vs.append(ctx_kv[3])
        xs, _ = trunk_layer(xs, mod_lat, (cache_na_k[:, l], cache_na_v[:, l], cache_da_k[:, l], cache_da_v[:, l]),
                            lam_init, *lp)
    y_prompt = rmsnorm(xp, norm_final)
    y_sample = rmsnorm(xs, norm_final)
    new_na_k = jnp.stack(na_ks, axis=1)
    new_na_v = jnp.stack(na_vs, axis=1)
    new_da_k = jnp.stack(da_ks, axis=1)
    new_da_v = jnp.stack(da_vs, axis=1)
    return (y_prompt, y_sample, new_na_k, new_na_v, new_da_k, new_da_v)
```

```cpp
#include <hip/hip_runtime.h>
#include <hip/hip_cooperative_groups.h>
#include <stdio.h>
namespace cg = cooperative_groups;

#define LAS __attribute__((address_space(3)))
typedef unsigned short u16;
using bf16x8 = __attribute__((ext_vector_type(8))) short;
using f32x16 = __attribute__((ext_vector_type(16))) float;
using u32x4 = __attribute__((ext_vector_type(4))) unsigned;
using u32x2 = __attribute__((ext_vector_type(2))) unsigned;

struct Params {
  const float *x_prompt, *x_sample, *cna_k, *cna_v, *cda_k, *cda_v, *c, *c_ctx, *w_ada, *b_ada, *norm_mix,
      *norm_ffn, *w_in, *hy_conv_w, *hy_conv_b, *fw1, *fb1, *fw2, *fb2, *fw3, *ffreq, *hy_bias, *na_rpb,
      *da_lambda, *da_subln, *w_lift, *w_out, *w_ffn_in, *w_ffn_out, *norm_final;
  float* out;
  char* ws;
};

constexpr int T_TOK = 24576;
constexpr int NPR = 8192;
constexpr long OFF_URM = 0;
constexpr long OFF_UHYT = OFF_URM + 24576L * 6144 * 2;
constexpr long OFF_YHY = OFF_UHYT + 1536L * 24576 * 2;
constexpr long OFF_HBUF = OFF_YHY + 24576L * 512 * 2;
constexpr long OFF_WTIN = OFF_HBUF + 24576L * 1024 * 2;
constexpr long OFF_WTLIFT = OFF_WTIN + 7680L * 1024 * 2;
constexpr long OFF_WTOUT = OFF_WTLIFT + 3L * 1024 * 512 * 2;
constexpr long OFF_WTFFI = OFF_WTOUT + 1024L * 1024 * 2;
constexpr long OFF_WTFFO = OFF_WTFFI + 5632L * 1024 * 2;
constexpr long OFF_FILT1 = OFF_WTFFO + 1024L * 2816 * 2;
constexpr long OFF_FILT0 = OFF_FILT1 + 2L * 512 * 8192 * 2;
constexpr long OFF_FPART = OFF_FILT0 + 2L * 512 * 512 * 2;
constexpr long OFF_MOD = OFF_FPART + 136L * 2048 * 4;
constexpr long OFF_ROPE = OFF_MOD + 4L * 5 * 6144 * 4;
constexpr long OFF_LAM = OFF_ROPE + 4096;
constexpr long OFF_BAR = OFF_LAM + 256;
constexpr long OFF_CTX = OFF_BAR + 16384;
constexpr long WS_NEED = OFF_CTX + 4L * 524288 * 2;

constexpr long OUT_NAK = 24576L * 1024;
constexpr long OUT_SZ = 32L * 4 * 256 * 512;

constexpr int HALF_BYTES = 73728;
constexpr int SMEM_BYTES = 2 * HALF_BYTES;

typedef __attribute__((ext_vector_type(2))) __bf16 bf2_t;
typedef __attribute__((ext_vector_type(2))) float f2_t;
__device__ __forceinline__ unsigned pk2(float a, float b) {
  f2_t v = {a, b};
  return __builtin_bit_cast(unsigned, __builtin_convertvector(v, bf2_t));
}
__device__ __forceinline__ u16 f2bf(float f) { return (u16)(pk2(f, 0.f) & 0xffffu); }
__device__ __forceinline__ float bf2f(u16 b) { return __uint_as_float(((unsigned)b) << 16); }
__device__ __forceinline__ f32x16 mfma32(bf16x8 a, bf16x8 b, f32x16 c) {
  return __builtin_amdgcn_mfma_f32_32x32x16_bf16(a, b, c, 0, 0, 0);
}
__device__ __forceinline__ f32x16 zero16() {
  f32x16 z;
#pragma unroll
  for (int i = 0; i < 16; ++i) z[i] = 0.f;
  return z;
}
__device__ __forceinline__ int otid512() {
  int t = threadIdx.x;
  asm volatile("" : "+v"(t));
  return t;
}
__device__ __forceinline__ int otid() { return otid512() & 255; }
__device__ __forceinline__ float shx(float v, int lane, int mask) {
  return __int_as_float(__builtin_amdgcn_ds_bpermute((lane ^ mask) << 2, __float_as_int(v)));
}
__device__ __forceinline__ int clampi(int v, int lo, int hi) { return v < lo ? lo : (v > hi ? hi : v); }
__device__ __forceinline__ int rowmap(int g, int h) { return (g & 3) + 8 * (g >> 2) + 4 * h; }

constexpr int GEMM_STAGE = 2 * 128 * 72;
#define GEMM_LOAD(RA, RB, KOFF)                                                                      \
  {                                                                                                 \
    _Pragma("unroll") for (int i = 0; i < 4; ++i) RA[i] = *(const u32x4*)(ap + (long)(32 * i) * lda + (KOFF));        \
    _Pragma("unroll") for (int i = 0; i < 2 * NJ; ++i) RB[i] = *(const u32x4*)(bp + (long)(32 * i) * ldb + (KOFF));   \
  }
#define GEMM_STORE(RA, RB, STG)                                                                     \
  {                                                                                                 \
    u16* nA_ = sm + (STG) * GEMM_STAGE;                                                             \
    _Pragma("unroll") for (int i = 0; i < 4; ++i) *(u32x4*)(nA_ + (lrow + 32 * i) * 72 + lkc) = RA[i];               \
    _Pragma("unroll") for (int i = 0; i < 2 * NJ; ++i) *(u32x4*)(nA_ + 128 * 72 + (lrow + 32 * i) * 72 + lkc) = RB[i]; \
  }
#define GEMM_COMPUTE_HALF(STG, KS0)                                                                 \
  {                                                                                                 \
    const u16* sA = sm + (STG) * GEMM_STAGE;                                                        \
    const u16* sB = sA + 128 * 72;                                                                  \
    __builtin_amdgcn_s_setprio(1);                                                                  \
    _Pragma("unroll") for (int ks = (KS0); ks < (KS0) + 2; ++ks) {                                  \
      bf16x8 af[2], bfr[NJ];                                                                        \
      _Pragma("unroll") for (int i = 0; i < 2; ++i) af[i] = *(const bf16x8*)(sA + (wm * 64 + i * 32 + r) * 72 + ks * 16 + h * 8); \
      _Pragma("unroll") for (int j = 0; j < NJ; ++j) bfr[j] = *(const bf16x8*)(sB + (wn * 32 * NJ + j * 32 + r) * 72 + ks * 16 + h * 8); \
      _Pragma("unroll") for (int i = 0; i < 2; ++i)                                                 \
        _Pragma("unroll") for (int j = 0; j < NJ; ++j)                                              \
          acc[i][j] = SWAP ? mfma32(bfr[j], af[i], acc[i][j]) : mfma32(af[i], bfr[j], acc[i][j]);   \
    }                                                                                               \
    __builtin_amdgcn_s_setprio(0);                                                                  \
  }

template <bool SWAP, int NJ>
__device__ __forceinline__ void gemm_tile(f32x16 (&acc)[2][NJ], const u16* __restrict__ A, long lda,
                                          const u16* __restrict__ B, long ldb, int K, u16* sm) {
  const int tid = otid(), lane = tid & 63, w = tid >> 6, wm = w & 1, wn = w >> 1, r = lane & 31, h = lane >> 5;
  const int lrow = tid >> 3, lkc = (tid & 7) * 8;
  const u16* ap = A + (long)lrow * lda + lkc;
  const u16* bp = B + (long)lrow * ldb + lkc;
  const int nk = K >> 6;
  u32x4 ra0[4], rb0[2 * NJ];
  GEMM_LOAD(ra0, rb0, 0)
  __syncthreads();
  GEMM_STORE(ra0, rb0, 0)
  GEMM_LOAD(ra0, rb0, 64)
  __syncthreads();
#pragma unroll 1
  for (int k = 0; k < nk; ++k) {
    const int cur = k & 1;
    GEMM_COMPUTE_HALF(cur, 0)
    __builtin_amdgcn_sched_barrier(0);
    if (k + 1 < nk) GEMM_STORE(ra0, rb0, cur ^ 1)
    if (k + 2 < nk) GEMM_LOAD(ra0, rb0, (k + 2) * 64)
    __builtin_amdgcn_sched_barrier(0);
    GEMM_COMPUTE_HALF(cur, 2)
    __syncthreads();
  }
}

__device__ __forceinline__ void stage_store(const u16* sC, int lds_ld, int cpr_log2, int nchunks, u16* dst, long ld) {
  const int tid = otid();
  __syncthreads();
  for (int ch = tid; ch < nchunks; ch += 256) {
    int row = ch >> cpr_log2, c8 = (ch & ((1 << cpr_log2) - 1)) * 8;
    *(u32x4*)(dst + (long)row * ld + c8) = *(const u32x4*)(sC + row * lds_ld + c8);
  }
}

__device__ __forceinline__ void zero_acc(f32x16 (&acc)[2][2]) {
#pragma unroll
  for (int i = 0; i < 2; ++i)
#pragma unroll
    for (int j = 0; j < 2; ++j) acc[i][j] = zero16();
}

__device__ __forceinline__ const float* xin_row(const Params& p, int l, int row) {
  if (l == 0) return row < NPR ? p.x_prompt + (long)row * 1024 : p.x_sample + (long)(row - NPR) * 1024;
  return p.out + (long)row * 1024;
}
__device__ __forceinline__ const float* mod_row(const Params& p, int l, int row) {
  int mi = row < NPR ? 0 : 1 + ((row - NPR) >> 12);
  return (const float*)(p.ws + OFF_MOD) + (long)(l * 5 + mi) * 6144;
}

__device__ __forceinline__ void phase0_item(const Params& p, int it, char* smem) {
  const int tid = otid();
  __syncthreads();
  if (it < 768) {
    float* s = (float*)smem;
    float* red = s + 5120;
    for (int i = tid; i < 5120; i += 256) {
      int v = i >> 10, k = i & 1023;
      float x = v == 0 ? p.c_ctx[k] : p.c[(v - 1) * 1024 + k];
      s[i] = x / (1.f + expf(-x));
    }
    __syncthreads();
    const int l = it / 192, grp = it % 192, col = tid & 31, kg = tid >> 5;
    const int n = grp * 32 + col;
    const float* W = p.w_ada + (long)l * 1024 * 6144 + n;
    float a0 = 0, a1 = 0, a2 = 0, a3 = 0, a4 = 0;
#pragma unroll 16
    for (int kk = 0; kk < 128; ++kk) {
      const int k = kg * 128 + kk;
      float wv = W[(long)k * 6144];
      a0 += s[k] * wv;
      a1 += s[1024 + k] * wv;
      a2 += s[2048 + k] * wv;
      a3 += s[3072 + k] * wv;
      a4 += s[4096 + k] * wv;
    }
    red[(kg * 5 + 0) * 32 + col] = a0;
    red[(kg * 5 + 1) * 32 + col] = a1;
    red[(kg * 5 + 2) * 32 + col] = a2;
    red[(kg * 5 + 3) * 32 + col] = a3;
    red[(kg * 5 + 4) * 32 + col] = a4;
    __syncthreads();
    if (tid < 160) {
      const int v = tid >> 5, cc = tid & 31;
      float t = p.b_ada[l * 6144 + grp * 32 + cc];
#pragma unroll
      for (int g = 0; g < 8; ++g) t += red[(g * 5 + v) * 32 + cc];
      ((float*)(p.ws + OFF_MOD))[(long)(l * 5 + v) * 6144 + grp * 32 + cc] = t;
    }
  } else if (it == 768) {
    float* rc = (float*)(p.ws + OFF_ROPE);
    for (int i = tid; i < 512; i += 256) {
      int pos = i >> 3, f = i & 7;
      float inv = powf(10000.f, -(float)f / 8.f);
      float ang = (float)pos * inv;
      rc[i] = cosf(ang);
      rc[512 + i] = sinf(ang);
    }
    if (tid < 4) {
      const float* lp = p.da_lambda + tid * 128;
      float s01 = 0, s23 = 0;
      for (int i = 0; i < 32; ++i) {
        s01 += lp[i] * lp[32 + i];
        s23 += lp[64 + i] * lp[96 + i];
      }
      float lam_init = 0.8f - 0.6f * expf(-0.3f * (float)tid);
      ((float*)(p.ws + OFF_LAM))[tid] = expf(s01) - expf(s23) + lam_init;
      ((float*)(p.ws + OFF_LAM))[4 + tid] = 1.f - lam_init;
    }
  }
}

__device__ __forceinline__ void norm_item(const Params& p, int l, int which, int item) {
  const int tid = otid(), lane = tid & 63, w = tid >> 6;
  const int row0 = item * 8 + w * 2;
  const float* g = (which == 0 ? p.norm_mix : p.norm_ffn) + l * 1024;
  float4 v[2][4];
  float ss[2];
#pragma unroll
  for (int rr = 0; rr < 2; ++rr) {
    const float* x = (which == 0) ? xin_row(p, l, row0 + rr) : p.out + (long)(row0 + rr) * 1024;
#pragma unroll
    for (int i = 0; i < 4; ++i) v[rr][i] = *(const float4*)(x + lane * 4 + 256 * i);
  }
#pragma unroll
  for (int rr = 0; rr < 2; ++rr) {
    float a = 0.f;
#pragma unroll
    for (int i = 0; i < 4; ++i)
      a += v[rr][i].x * v[rr][i].x + v[rr][i].y * v[rr][i].y + v[rr][i].z * v[rr][i].z + v[rr][i].w * v[rr][i].w;
#pragma unroll
    for (int o = 32; o >= 1; o >>= 1) a += shx(a, lane, o);
    ss[rr] = rsqrtf(a * (1.f / 1024.f) + 1e-6f);
  }
  const float* mp = mod_row(p, l, row0) + which * 3072;
#pragma unroll
  for (int i = 0; i < 4; ++i) {
    int c = lane * 4 + 256 * i;
    float4 gg = *(const float4*)(g + c);
    float4 sh = *(const float4*)(mp + c);
    float4 sc = *(const float4*)(mp + 1024 + c);
#pragma unroll
    for (int rr = 0; rr < 2; ++rr) {
      const float rs = ss[rr];
      float y0 = v[rr][i].x * rs * gg.x * (1.f + sc.x) + sh.x;
      float y1 = v[rr][i].y * rs * gg.y * (1.f + sc.y) + sh.y;
      float y2 = v[rr][i].z * rs * gg.z * (1.f + sc.z) + sh.z;
      float y3 = v[rr][i].w * rs * gg.w * (1.f + sc.w) + sh.w;
      u32x2 o2;
      o2[0] = pk2(y0, y1);
      o2[1] = pk2(y2, y3);
      *(u32x2*)((u16*)(p.ws + OFF_HBUF) + (long)(row0 + rr) * 1024 + c) = o2;
    }
  }
}

__device__ __forceinline__ void final_norm_item(const Params& p, int item) {
  const int tid = otid(), lane = tid & 63, w = tid >> 6;
  const int row = item * 4 + w;
  float* x = p.out + (long)row * 1024;
  float4 v[4];
  float ss = 0;
#pragma unroll
  for (int i = 0; i < 4; ++i) {
    v[i] = *(const float4*)(x + lane * 4 + 256 * i);
    ss += v[i].x * v[i].x + v[i].y * v[i].y + v[i].z * v[i].z + v[i].w * v[i].w;
  }
#pragma unroll
  for (int o = 32; o >= 1; o >>= 1) ss += shx(ss, lane, o);
  const float rs = rsqrtf(ss * (1.f / 1024.f) + 1e-6f);
#pragma unroll
  for (int i = 0; i < 4; ++i) {
    int c = lane * 4 + 256 * i;
    float4 gg = *(const float4*)(p.norm_final + c);
    float4 o;
    o.x = v[i].x * rs * gg.x;
    o.y = v[i].y * rs * gg.y;
    o.z = v[i].z * rs * gg.z;
    o.w = v[i].w * rs * gg.w;
    *(float4*)(x + c) = o;
  }
}

__device__ __forceinline__ void ctx_convert_item(const Params& p, int l, int item) {
  const int tid = otid();
  const int t = item >> 7, e0 = (item & 127) * 4096, b = e0 >> 17, j0 = e0 & 131071;
  const float* const* kargs = (const float* const*)__builtin_amdgcn_kernarg_segment_ptr();
  const float* srcb = kargs[2 + __builtin_amdgcn_readfirstlane(t)];
  const float* src = srcb + ((long)(b * 4 + l) << 17) + j0 + tid * 16;
  u16* dst = (u16*)(p.ws + OFF_CTX) + (long)t * 524288 + e0 + tid * 16;
  float4 v0 = *(const float4*)src, v1 = *(const float4*)(src + 4), v2 = *(const float4*)(src + 8), v3 = *(const float4*)(src + 12);
  u32x4 o0, o1;
  o0[0] = pk2(v0.x, v0.y); o0[1] = pk2(v0.z, v0.w); o0[2] = pk2(v1.x, v1.y); o0[3] = pk2(v1.z, v1.w);
  o1[0] = pk2(v2.x, v2.y); o1[1] = pk2(v2.z, v2.w); o1[2] = pk2(v3.x, v3.y); o1[3] = pk2(v3.z, v3.w);
  *(u32x4*)dst = o0;
  *(u32x4*)(dst + 8) = o1;
}

__device__ __forceinline__ int colmap(int n, int mode) {
  if (mode == 0) return n;
  return ((n >> 4) & 1) * 2816 + (n >> 5) * 16 + (n & 15);
}
__device__ __forceinline__ void conv_tile(const float* __restrict__ src, int ldsrc, u16* __restrict__ dst, int K, int k0, int n0,
                          int mode, char* smem) {
  float* tile = (float*)smem;
  const int tid = otid();
  __syncthreads();
#pragma unroll
  for (int i = 0; i < 4; ++i) {
    int kk = (tid >> 4) + 16 * i, nn = (tid & 15) * 4;
    int sc = colmap(n0 + nn, mode);
    float4 v = *(const float4*)(src + (long)(k0 + kk) * ldsrc + sc);
    tile[kk * 65 + nn] = v.x;
    tile[kk * 65 + nn + 1] = v.y;
    tile[kk * 65 + nn + 2] = v.z;
    tile[kk * 65 + nn + 3] = v.w;
  }
  __syncthreads();
  const int n = tid >> 2, kc = (tid & 3) * 16;
  u32x4 o0, o1;
#pragma unroll
  for (int e = 0; e < 4; ++e) {
    o0[e] = pk2(tile[(kc + 2 * e) * 65 + n], tile[(kc + 2 * e + 1) * 65 + n]);
    o1[e] = pk2(tile[(kc + 8 + 2 * e) * 65 + n], tile[(kc + 8 + 2 * e + 1) * 65 + n]);
  }
  u16* d = dst + (long)(n0 + n) * K + k0 + kc;
  *(u32x4*)d = o0;
  *(u32x4*)(d + 8) = o1;
}

__device__ __forceinline__ void convert_item(const Params& p, int l, int it, char* smem) {
  if (it < 1920) {
    int kt = it / 120, nt = it % 120;
    conv_tile(p.w_in + (long)l * 1024 * 7680, 7680, (u16*)(p.ws + OFF_WTIN), 1024, kt * 64, nt * 64, 0, smem);
  } else if (it < 2304) {
    int j = it - 1920, br = j / 128, rr = j % 128, kt = rr / 16, nt = rr % 16;
    conv_tile(p.w_lift + ((long)l * 3 + br) * 512 * 1024, 1024, (u16*)(p.ws + OFF_WTLIFT) + (long)br * 1024 * 512, 512,
              kt * 64, nt * 64, 0, smem);
  } else if (it < 2560) {
    int j = it - 2304, kt = j / 16, nt = j % 16;
    conv_tile(p.w_out + (long)l * 1024 * 1024, 1024, (u16*)(p.ws + OFF_WTOUT), 1024, kt * 64, nt * 64, 0, smem);
  } else if (it < 3968) {
    int j = it - 2560, kt = j / 88, nt = j % 88;
    conv_tile(p.w_ffn_in + (long)l * 1024 * 5632, 5632, (u16*)(p.ws + OFF_WTFFI), 1024, kt * 64, nt * 64, 1, smem);
  } else {
    int j = it - 3968, kt = j / 16, nt = j % 16;
    conv_tile(p.w_ffn_out + (long)l * 2816 * 1024, 1024, (u16*)(p.ws + OFF_WTFFO), 2816, kt * 64, nt * 64, 0, smem);
  }
}

__device__ __forceinline__ void filter_item(const Params& p, int l, int ci, int sub, char* smem) {
  const int tid = otid();
  float* feats = (float*)smem;
  float* h1 = feats + 32 * 33;
  float* h2T = h1 + 2048;
  float* sw1 = h2T + 2048;
  float* sw2 = sw1 + 33 * 64;
  const int L = ci < 128 ? 4096 : 256;
  const int t0 = (ci < 128 ? ci : ci - 128) * 32;
  const float* w1 = p.fw1 + l * 33 * 64;
  const float* b1 = p.fb1 + l * 64;
  const float* w2 = p.fw2 + l * 64 * 64;
  const float* b2 = p.fb2 + l * 64;
  const float* w3 = p.fw3 + (long)l * 64 * 2048;
  const float* fr = p.ffreq + l * 64;
  __syncthreads();
  for (int e = tid; e < 33 * 64; e += 256) sw1[e] = w1[e];
  for (int e = tid; e < 64 * 64; e += 256) sw2[e] = w2[e];
  for (int e = tid; e < 32 * 33; e += 256) {
    int tt = e / 33, f = e % 33;
    float pos = (float)(t0 + tt);
    float val;
    if (f == 0) {
      val = pos / (float)L;
    } else {
      int bi = (f - 1) & 15;
      float band = 1e-4f + (15.f - 1e-4f) * (float)bi / 15.f;
      float ang = (6.283185307179586f / (float)L) * pos * band;
      val = f <= 16 ? cosf(ang) : -sinf(ang);
    }
    feats[e] = val;
  }
  __syncthreads();
  for (int e = tid; e < 2048; e += 256) {
    int tt = e >> 6, j = e & 63;
    float s = b1[j];
#pragma unroll 11
    for (int f = 0; f < 33; ++f) s += feats[tt * 33 + f] * sw1[f * 64 + j];
    h1[e] = sinf(fr[j] * s);
  }
  __syncthreads();
  for (int e = tid; e < 2048; e += 256) {
    int tt = e >> 6, j = e & 63;
    float s = b2[j];
#pragma unroll 16
    for (int k = 0; k < 64; ++k) s += h1[tt * 64 + k] * sw2[k * 64 + j];
    h2T[j * 32 + tt] = sinf(fr[j] * s);
  }
  __syncthreads();
  const float d0 = -3.0701134573253945f;
  const float d1 = -15.350567286626973f;
  {
    const int n = sub * 256 + tid;
    const int o = n >> 10, dir = (n >> 9) & 1, c = n & 511;
    const float adelta = fabsf(d0 + (d1 - d0) * (float)c / 511.f);
    u16* G = (u16*)(p.ws + (L == 4096 ? OFF_FILT1 : OFF_FILT0)) + (long)(o * 512 + c) * (2 * L);
    float asum = 0.f;
    float acc[2][16];
#pragma unroll
    for (int tg = 0; tg < 2; ++tg)
#pragma unroll
      for (int i = 0; i < 16; ++i) acc[tg][i] = 0.f;
#pragma unroll 1
    for (int kg = 0; kg < 4; ++kg) {
      float wv[16];
#pragma unroll
      for (int i = 0; i < 16; ++i) wv[i] = w3[(kg * 16 + i) * 2048 + n];
#pragma unroll
      for (int i = 0; i < 16; ++i) {
        const int k = kg * 16 + i;
#pragma unroll
        for (int tg = 0; tg < 2; ++tg)
#pragma unroll
          for (int q = 0; q < 4; ++q) {
            float4 hv = *(const float4*)(h2T + k * 32 + tg * 16 + q * 4);
            acc[tg][4 * q + 0] += hv.x * wv[i];
            acc[tg][4 * q + 1] += hv.y * wv[i];
            acc[tg][4 * q + 2] += hv.z * wv[i];
            acc[tg][4 * q + 3] += hv.w * wv[i];
          }
      }
    }
#pragma unroll
    for (int tg = 0; tg < 2; ++tg) {
#pragma unroll
      for (int tt = 0; tt < 16; ++tt) {
        int t = t0 + tg * 16 + tt;
        float val = acc[tg][tt] * expf(-((float)t / (float)L) * adelta);
        if (dir == 0 || t > 0) {
          asum += fabsf(val);
          G[dir ? L + t : L - t] = f2bf(val);
        }
      }
    }
    ((float*)(p.ws + OFF_FPART))[(long)ci * 2048 + n] = asum;
  }
}


using f32x4v = __attribute__((ext_vector_type(4))) float;
constexpr int F_BK = 64, F_HALF = 128, F_HT = F_HALF * F_BK;
__device__ __forceinline__ int f_lds_byte(int r, int c) {
  int st = (r >> 4) * 2 + (c >> 5), rr = r & 15, cc = c & 31, ob = rr * 64 + cc * 2;
  return st * 1024 + (ob ^ (((ob >> 9) & 1) << 5));
}
__device__ __forceinline__ void f_stage_rc(int b, int& R, int& C) {
  int st = b / 1024, sb = b % 1024, swz = sb ^ (((sb >> 9) & 1) << 5);
  R = (st >> 1) * 16 + swz / 64;
  C = (st & 1) * 32 + (swz % 64) / 2;
}
#define F_SA(b, h) (shm + ((b) * 2 + (h)) * F_HT)
#define F_SB(b, h) (shm + (4 + (b) * 2 + (h)) * F_HT)
#define F_STAGE(P, BASE, PITCH, br, kt)                                                              \
  do {                                                                                              \
    long _g = (long)(br) * (PITCH) + (long)(kt) * F_BK;                                             \
    for (int _i = 0; _i < 2; ++_i) {                                                                \
      int _b = tid * 16 + _i * 8192;                                                                \
      int _r, _c;                                                                                   \
      f_stage_rc(_b, _r, _c);                                                                       \
      __builtin_amdgcn_global_load_lds((const unsigned*)((BASE) + _g + (long)_r * (PITCH) + _c),    \
                                       (LAS unsigned*)((LAS char*)(P) + _b), 16, 0, 0);            \
    }                                                                                               \
  } while (0)
#define F_LDA(dst, b, h)                                                                            \
  for (int m = 0; m < 4; ++m)                                                                       \
    for (int k = 0; k < 2; ++k)                                                                     \
      dst[m][k] = *reinterpret_cast<const LAS bf16x8*>((const LAS char*)F_SA(b, h) + f_lds_byte(wr * 64 + m * 16 + fr, k * 32 + fq * 8))
#define F_LDB(dst, b, h)                                                                            \
  for (int n = 0; n < 2; ++n)                                                                       \
    for (int k = 0; k < 2; ++k)                                                                     \
      dst[n][k] = *reinterpret_cast<const LAS bf16x8*>((const LAS char*)F_SB(b, h) + f_lds_byte(wc * 32 + n * 16 + fr, k * 32 + fq * 8))
#define F_MMA(ai, bj, At, Bt_)                                                                      \
  do {                                                                                              \
    __builtin_amdgcn_s_setprio(1);                                                                  \
    for (int m = 0; m < 4; ++m)                                                                     \
      for (int n = 0; n < 2; ++n)                                                                   \
        for (int k = 0; k < 2; ++k)                                                                 \
          acc[ai][bj][m][n] = __builtin_amdgcn_mfma_f32_16x16x32_bf16(At[m][k], Bt_[n][k], acc[ai][bj][m][n], 0, 0, 0); \
    __builtin_amdgcn_s_setprio(0);                                                                  \
  } while (0)
#define F_WAIT_V(n) asm volatile("s_waitcnt vmcnt(" #n ")" ::: "memory")
#define F_WAIT_L(n) asm volatile("s_waitcnt lgkmcnt(" #n ")" ::: "memory")
#define F_BAR __builtin_amdgcn_s_barrier()
#define F_SCHED __builtin_amdgcn_sched_barrier(0)

__device__ __forceinline__ void gemm256(f32x4v (&acc)[2][2][4][2], const u16* __restrict__ A, long lda,
                                        const u16* __restrict__ Bt, long ldb, int K, LAS u16* shm) {
  const int tid = otid512();
  const int wid = tid >> 6, lane = tid & 63, wr = wid >> 2, wc = wid & 3, fr = lane & 15, fq = lane >> 4;
#pragma unroll
  for (int a = 0; a < 2; ++a)
#pragma unroll
    for (int b = 0; b < 2; ++b)
#pragma unroll
      for (int m = 0; m < 4; ++m)
#pragma unroll
        for (int n = 0; n < 2; ++n) acc[a][b][m][n] = f32x4v{0.f, 0.f, 0.f, 0.f};
  bf16x8 At[4][2], B0[2][2], B1[2][2];
  const int nt = K / F_BK;
  asm volatile("s_waitcnt vmcnt(0) lgkmcnt(0)" ::: "memory");
  __syncthreads();
  F_STAGE(F_SB(0, 0), Bt, ldb, 0, 0); F_STAGE(F_SA(0, 0), A, lda, 0, 0);
  F_STAGE(F_SB(0, 1), Bt, ldb, F_HALF, 0); F_STAGE(F_SA(0, 1), A, lda, F_HALF, 0);
  if (wr == 1) F_BAR;
  F_WAIT_V(4); F_BAR;
  F_STAGE(F_SB(1, 0), Bt, ldb, 0, 1); F_STAGE(F_SA(1, 0), A, lda, 0, 1); F_STAGE(F_SB(1, 1), Bt, ldb, F_HALF, 1);
  F_WAIT_V(6); F_BAR;
#pragma unroll 1
  for (int t = 0; t < nt - 2; t += 2) {
    F_LDB(B0, 0, 0); F_SCHED; F_LDA(At, 0, 0); F_STAGE(F_SA(1, 1), A, lda, F_HALF, t + 1);
    F_WAIT_L(8); F_BAR; F_WAIT_L(0); F_MMA(0, 0, At, B0); F_BAR; F_SCHED;
    F_LDB(B1, 0, 1); F_STAGE(F_SB(0, 0), Bt, ldb, 0, t + 2);
    F_BAR; F_WAIT_L(0); F_MMA(0, 1, At, B1); F_BAR;
    F_LDA(At, 0, 1); F_STAGE(F_SA(0, 0), A, lda, 0, t + 2);
    F_BAR; F_WAIT_L(0); F_MMA(1, 0, At, B0); F_BAR; F_SCHED;
    F_STAGE(F_SB(0, 1), Bt, ldb, F_HALF, t + 2);
    F_WAIT_V(6); F_BAR; F_MMA(1, 1, At, B1); F_BAR;
    F_LDB(B0, 1, 0); F_SCHED; F_LDA(At, 1, 0); F_STAGE(F_SA(0, 1), A, lda, F_HALF, t + 2);
    F_WAIT_L(8); F_BAR; F_WAIT_L(0); F_MMA(0, 0, At, B0); F_BAR; F_SCHED;
    F_LDB(B1, 1, 1); F_STAGE(F_SB(1, 0), Bt, ldb, 0, t + 3);
    F_BAR; F_WAIT_L(0); F_MMA(0, 1, At, B1); F_BAR;
    F_LDA(At, 1, 1); F_STAGE(F_SA(1, 0), A, lda, 0, t + 3);
    F_BAR; F_WAIT_L(0); F_MMA(1, 0, At, B0); F_BAR; F_SCHED;
    F_STAGE(F_SB(1, 1), Bt, ldb, F_HALF, t + 3);
    F_WAIT_V(6); F_BAR; F_MMA(1, 1, At, B1); F_BAR;
  }
  {
    F_LDB(B0, 0, 0); F_LDA(At, 0, 0); F_STAGE(F_SA(1, 1), A, lda, F_HALF, nt - 1);
    F_BAR; F_WAIT_L(0); F_MMA(0, 0, At, B0); F_BAR;
    F_LDB(B1, 0, 1); F_BAR; F_WAIT_L(0); F_MMA(0, 1, At, B1); F_BAR;
    F_LDA(At, 0, 1); F_WAIT_V(4); F_BAR; F_WAIT_L(0); F_MMA(1, 0, At, B0); F_MMA(1, 1, At, B1); F_BAR;
  }
  {
    F_LDB(B0, 1, 0); F_LDA(At, 1, 0); F_WAIT_V(2); F_BAR; F_WAIT_L(0); F_MMA(0, 0, At, B0); F_BAR;
    F_LDB(B1, 1, 1); F_WAIT_V(0); F_BAR; F_WAIT_L(0); F_MMA(0, 1, At, B1); F_BAR;
    F_LDA(At, 1, 1); F_BAR; F_WAIT_L(0); F_MMA(1, 0, At, B0); F_MMA(1, 1, At, B1); F_BAR;
  }
  if (wr == 0) F_BAR;
}

__device__ __forceinline__ void stage_store512(const u16* sC, int lds_ld, int cpr_log2, int nchunks, u16* dst, long ld) {
  const int tid = otid512();
  __syncthreads();
  for (int ch = tid; ch < nchunks; ch += 512) {
    int row = ch >> cpr_log2, c8 = (ch & ((1 << cpr_log2) - 1)) * 8;
    *(u32x4*)(dst + (long)row * ld + c8) = *(const u32x4*)(sC + row * lds_ld + c8);
  }
}


#define F_FOREACH(BODY)                                                                             \
  _Pragma("unroll") for (int ai = 0; ai < 2; ++ai)                                                  \
  _Pragma("unroll") for (int bj = 0; bj < 2; ++bj)                                                  \
  _Pragma("unroll") for (int m = 0; m < 4; ++m)                                                     \
  _Pragma("unroll") for (int n = 0; n < 2; ++n)                                                     \
  _Pragma("unroll") for (int j = 0; j < 4; ++j) {                                                   \
    const int R = ai * 128 + wr * 64 + m * 16 + fq * 4 + j;                                         \
    const int C = bj * 128 + wc * 32 + n * 16 + fr;                                                 \
    BODY                                                                                            \
  }

__device__ __forceinline__ void gemm_in_fast(const Params& p, int l, int tile, LAS char* smem) {
  LAS u16* shm = (LAS u16*)smem;
  u16* sm = (u16*)smem;
  const int mt = tile / 30, nt = tile % 30, m0 = mt * 256, n0 = nt * 256;
  f32x4v acc[2][2][4][2];
  const u16* X = (const u16*)(p.ws + OFF_HBUF) + (long)m0 * 1024;
  const u16* W = (const u16*)(p.ws + OFF_WTIN) + (long)n0 * 1024;
  if (nt < 6) {
    gemm256(acc, W, 1024, X, 1024, 1024, shm);
    const int tid = otid512(), wid = tid >> 6, lane = tid & 63, wr = wid >> 2, wc = wid & 3, fr = lane & 15, fq = lane >> 4;
    F_FOREACH(sm[R * 264 + C] = f2bf(acc[ai][bj][m][n][j]);)
    stage_store512(sm, 264, 5, 8192, (u16*)(p.ws + OFF_UHYT) + (long)n0 * T_TOK + m0, T_TOK);
  } else {
    gemm256(acc, X, 1024, W, 1024, 1024, shm);
    const int tid = otid512(), wid = tid >> 6, lane = tid & 63, wr = wid >> 2, wc = wid & 3, fr = lane & 15, fq = lane >> 4;
    const int region = (n0 - 1536) >> 9;
    const bool prompt = m0 < NPR;
    const bool rope = (!prompt) && (region == 3 || region == 4);
    float* outp = nullptr;
    if (prompt) {
      if (region == 1) outp = p.out + OUT_NAK;
      else if (region == 2) outp = p.out + OUT_NAK + OUT_SZ;
      else if (region == 4) outp = p.out + OUT_NAK + 2 * OUT_SZ;
      else if (region == 5) outp = p.out + OUT_NAK + 3 * OUT_SZ;
    }
    const float* rc = (const float*)(p.ws + OFF_ROPE);
    F_FOREACH(
      const int mm = m0 + R; const int nn = n0 + C;
      float v = acc[ai][bj][m][n][j];
      if (rope) {
        float pr = shx(v, lane, 1);
        int d = nn & 31; int pi = d >> 1;
        int tq = (mm - NPR) & 4095;
        int pos = pi < 8 ? (tq >> 6) : (tq & 63);
        float cs = rc[pos * 8 + (pi & 7)]; float sn = rc[512 + pos * 8 + (pi & 7)];
        v = (nn & 1) ? (pr * sn + v * cs) : (v * cs - pr * sn);
      }
      sm[R * 264 + C] = f2bf(v);
      if (outp) outp[((long)((mm >> 8) * 4 + l) * 256 + (mm & 255)) * 512 + ((nn - 1536) & 511)] = v;
    )
    stage_store512(sm, 264, 5, 8192, (u16*)(p.ws + OFF_URM) + (long)m0 * 6144 + (n0 - 1536), 6144);
  }
}

__device__ __forceinline__ void ffn_in_fast(const Params& p, int l, int tile, LAS char* smem) {
  LAS u16* shm = (LAS u16*)smem;
  u16* sm = (u16*)smem;
  const int mt = tile / 22, nt = tile % 22, m0 = mt * 256, n0 = nt * 256;
  f32x4v acc[2][2][4][2];
  gemm256(acc, (const u16*)(p.ws + OFF_HBUF) + (long)m0 * 1024, 1024,
          (const u16*)(p.ws + OFF_WTFFI) + (long)n0 * 1024, 1024, 1024, shm);
  const int tid = otid512(), wid = tid >> 6, lane = tid & 63, wr = wid >> 2, wc = wid & 3, fr = lane & 15, fq = lane >> 4;
#pragma unroll
  for (int ai = 0; ai < 2; ++ai)
#pragma unroll
    for (int bj = 0; bj < 2; ++bj)
#pragma unroll
      for (int m = 0; m < 4; ++m)
#pragma unroll
        for (int j = 0; j < 4; ++j) {
          const int R = ai * 128 + wr * 64 + m * 16 + fq * 4 + j;
          const int C = bj * 64 + wc * 16 + fr;
          const float gv = acc[ai][bj][m][0][j], uv = acc[ai][bj][m][1][j];
          sm[R * 136 + C] = f2bf(gv / (1.f + __expf(-gv)) * uv);
        }
  stage_store512(sm, 136, 4, 4096, (u16*)(p.ws + OFF_URM) + (long)m0 * 2816 + nt * 128, 2816);
}

__device__ __forceinline__ void resid_fast(const Params& p, int l, int which, int tile, LAS char* smem) {
  LAS u16* shm = (LAS u16*)smem;
  const int mt = tile >> 2, nt = tile & 3, m0 = mt * 256, n0 = nt * 256;
  f32x4v acc[2][2][4][2];
  if (which == 0) {
    gemm256(acc, (const u16*)(p.ws + OFF_HBUF) + (long)m0 * 1024, 1024,
            (const u16*)(p.ws + OFF_WTOUT) + (long)n0 * 1024, 1024, 1024, shm);
  } else {
    gemm256(acc, (const u16*)(p.ws + OFF_URM) + (long)m0 * 2816, 2816,
            (const u16*)(p.ws + OFF_WTFFO) + (long)n0 * 2816, 2816, 2816, shm);
  }
  const int tid = otid512(), wid = tid >> 6, lane = tid & 63, wr = wid >> 2, wc = wid & 3, fr = lane & 15, fq = lane >> 4;
  const float* gate = mod_row(p, l, m0) + (which == 0 ? 2048 : 5120) + n0;
  const float* xbase = ((which == 0 && l == 0) ? (m0 < NPR ? p.x_prompt + (long)m0 * 1024 : p.x_sample + (long)(m0 - NPR) * 1024)
                                               : p.out + (long)m0 * 1024) + n0;
  float* obase = p.out + (long)m0 * 1024 + n0;
  F_FOREACH(
    obase[R * 1024 + C] = xbase[R * 1024 + C] + gate[C] * acc[ai][bj][m][n][j];
  )
}

__device__ __forceinline__ void tile_swz(int it, int ncg, int& mt, int& nt) {
  const int x = it & 7, q = it >> 3;
  const int g = q >> 5, e = q & 31;
  const int sid = x * (3 * ncg) + g;
  const int smt = sid / ncg, snt = sid - smt * ncg;
  mt = smt * 8 + (e >> 2);
  nt = snt * 4 + (e & 3);
}

__device__ __forceinline__ void gemm_in_item(const Params& p, int l, int tile, char* smem) {
  u16* sm = (u16*)smem;
  const int tid = otid(), lane = tid & 63, w = tid >> 6, wm = w & 1, wn = w >> 1, r = lane & 31, h = lane >> 5;
  int mt, nt;
  tile_swz(tile, 15, mt, nt);
  const int m0 = mt * 128, n0 = nt * 128;
  f32x16 acc[2][2];
  zero_acc(acc);
  const u16* A = (const u16*)(p.ws + OFF_HBUF) + (long)m0 * 1024;
  const u16* B = (const u16*)(p.ws + OFF_WTIN) + (long)n0 * 1024;
  if (nt < 12) {
    gemm_tile<true, 2>(acc, A, 1024, B, 1024, 1024, sm);
#pragma unroll
    for (int i = 0; i < 2; ++i)
#pragma unroll
      for (int j = 0; j < 2; ++j)
#pragma unroll
        for (int g = 0; g < 16; ++g) {
          int R = wn * 64 + j * 32 + rowmap(g, h);
          int C = wm * 64 + i * 32 + r;
          sm[R * 136 + C] = f2bf(acc[i][j][g]);
        }
    stage_store(sm, 136, 4, 2048, (u16*)(p.ws + OFF_UHYT) + (long)n0 * T_TOK + m0, T_TOK);
  } else {
    gemm_tile<false, 2>(acc, A, 1024, B, 1024, 1024, sm);
    const int region = (n0 - 1536) >> 9;
    const bool prompt = m0 < NPR;
    const bool rope = (!prompt) && (region == 3 || region == 4);
    float* outp = nullptr;
    if (prompt) {
      if (region == 1) outp = p.out + OUT_NAK;
      else if (region == 2) outp = p.out + OUT_NAK + OUT_SZ;
      else if (region == 4) outp = p.out + OUT_NAK + 2 * OUT_SZ;
      else if (region == 5) outp = p.out + OUT_NAK + 3 * OUT_SZ;
    }
    const float* rc = (const float*)(p.ws + OFF_ROPE);
#pragma unroll
    for (int i = 0; i < 2; ++i)
#pragma unroll
      for (int j = 0; j < 2; ++j)
#pragma unroll
        for (int g = 0; g < 16; ++g) {
          int R = wm * 64 + i * 32 + rowmap(g, h);
          int C = wn * 64 + j * 32 + r;
          int m = m0 + R, n = n0 + C;
          float v = acc[i][j][g];
          if (rope) {
            float pr = shx(v, lane, 1);
            int d = n & 31, pi = d >> 1;
            int tq = (m - NPR) & 4095;
            int pos = pi < 8 ? (tq >> 6) : (tq & 63);
            float cs = rc[pos * 8 + (pi & 7)], sn = rc[512 + pos * 8 + (pi & 7)];
            v = (n & 1) ? (pr * sn + v * cs) : (v * cs - pr * sn);
          }
          sm[R * 136 + C] = f2bf(v);
          if (outp) outp[((long)((m >> 8) * 4 + l) * 256 + (m & 255)) * 512 + ((n - 1536) & 511)] = v;
        }
    stage_store(sm, 136, 4, 2048, (u16*)(p.ws + OFF_URM) + (long)m0 * 6144 + (n0 - 1536), 6144);
  }
}

__device__ __forceinline__ void lift_item(const Params& p, int l, int tile, char* smem) {
  constexpr int NJ = 1;
  constexpr bool SWAP = false;
  u16* sm = (u16*)smem;
  const int tid = otid(), lane = tid & 63, w = tid >> 6, wm = w & 1, wn = w >> 1, r = lane & 31, h = lane >> 5;
  int mt, nt;
  tile_swz(tile, 4, mt, nt);
  const int m0 = mt * 128, n0 = nt * 64;
  const u16* urm = (const u16*)(p.ws + OFF_URM);
  const int lrow = tid >> 3, lkc = (tid & 7) * 8;
  const u16* a0p = (const u16*)(p.ws + OFF_YHY) + (long)(m0 + lrow) * 512 + lkc;
  const u16* a1p = urm + (long)(m0 + lrow) * 6144 + lkc;
  const u16* b0p = (const u16*)(p.ws + OFF_WTLIFT) + (long)(n0 + lrow) * 512 + lkc;
  f32x16 tot[2], acc[2][1];
  tot[0] = zero16();
  tot[1] = zero16();
  acc[0][0] = zero16();
  acc[1][0] = zero16();
  u32x4 ra0[4], rb0[2], ra1[4], rb1[2], ra2[4], rb2[2], ra3[4], rb3[2];
#define LIFT_LOAD(RA, RB, KI)                                                                       \
  {                                                                                                 \
    const int ki_ = ((KI) < 24) ? (KI) : 23;     \
    const int seg_ = ki_ >> 3, kk_ = (ki_ & 7) * 64;                                                \
    const u16* ap = (seg_ == 0) ? (a0p + kk_) : (a1p + (seg_ == 1 ? 0 : 1536) + kk_);               \
    const long lda = (seg_ == 0) ? 512 : 6144;                                                      \
    const u16* bp = b0p + (long)seg_ * 1024 * 512 + kk_;                                            \
    const long ldb = 512;                                                                           \
    GEMM_LOAD(RA, RB, 0)                                                                            \
  }
#define LIFT_STEP(K, RA, RB)                                                                        \
  {                                                                                                 \
    const int k = (K);                                                                              \
    const int cur = k & 1;                                                                          \
    if ((k & 7) == 0) {                                                                             \
      const int br = k >> 3;                                                                        \
      _Pragma("unroll") for (int i = 0; i < 2; ++i)                                                 \
        _Pragma("unroll") for (int g = 0; g < 16; ++g) {                                            \
          int m = m0 + wm * 64 + i * 32 + rowmap(g, h);                                             \
          int n = n0 + wn * 32 + r;                                                                 \
          gq[i][g] = urm[(long)m * 6144 + 3072 + br * 1024 + n];                                    \
        }                                                                                           \
    }                                                                                               \
    GEMM_COMPUTE_HALF(cur, 0)                                                                       \
    __builtin_amdgcn_sched_barrier(0);                                                              \
    if (k + 1 < 24) GEMM_STORE(RA, RB, cur ^ 1)                                                     \
    LIFT_LOAD(RA, RB, k + 5)                                                                        \
    __builtin_amdgcn_sched_barrier(0);                                                              \
    GEMM_COMPUTE_HALF(cur, 2)                                                                       \
    __syncthreads();                                                                                \
    if ((k & 7) == 7) {                                                                             \
      _Pragma("unroll") for (int i = 0; i < 2; ++i)                                                 \
        _Pragma("unroll") for (int g = 0; g < 16; ++g) {                                            \
          float gt = bf2f(gq[i][g]);                                                                \
          tot[i][g] += acc[i][0][g] / (1.f + __expf(-gt));                                          \
          acc[i][0][g] = 0.f;                                                                       \
        }                                                                                           \
    }                                                                                               \
  }
  LIFT_LOAD(ra0, rb0, 0)
  LIFT_LOAD(ra1, rb1, 1)
  LIFT_LOAD(ra2, rb2, 2)
  LIFT_LOAD(ra3, rb3, 3)
  __syncthreads();
  GEMM_STORE(ra0, rb0, 0)
  LIFT_LOAD(ra0, rb0, 4)
  __syncthreads();
  u16 gq[2][16];
#pragma unroll 1
  for (int kk = 0; kk < 24; kk += 4) {
    LIFT_STEP(kk + 0, ra1, rb1)
    LIFT_STEP(kk + 1, ra2, rb2)
    LIFT_STEP(kk + 2, ra3, rb3)
    LIFT_STEP(kk + 3, ra0, rb0)
  }
#undef LIFT_STEP
#undef LIFT_LOAD
#pragma unroll
  for (int i = 0; i < 2; ++i)
#pragma unroll
    for (int g = 0; g < 16; ++g) {
      int R = wm * 64 + i * 32 + rowmap(g, h);
      int C = wn * 32 + r;
      sm[R * 72 + C] = f2bf(tot[i][g]);
    }
  stage_store(sm, 72, 3, 1024, (u16*)(p.ws + OFF_HBUF) + (long)m0 * 1024 + n0, 1024);
}


__device__ __forceinline__ void lift_pair_item(const Params& p, int l, int pair, char* smem) {
  const int tid = otid512(), half = tid >> 8, ht = tid & 255;
  const int lane = ht & 63, w = ht >> 6, wm = w & 1, wn = w >> 1, r = lane & 31, h = lane >> 5;
  u16* sAall = (u16*)smem;
  u16* sBme = (u16*)smem + 2 * 128 * 72 + half * (2 * 64 * 72);
  u16* sOut = (u16*)smem + 2 * 128 * 72 + 2 * (2 * 64 * 72) + half * (128 * 72);
  int mt, ntp;
  tile_swz(pair, 2, mt, ntp);
  const int m0 = mt * 128, n0 = (2 * ntp + half) * 64;
  const u16* urm = (const u16*)(p.ws + OFF_URM);
  const int arow = tid >> 3, akc = (tid & 7) * 8;
  const int brow = ht >> 3, bkc = (ht & 7) * 8;
  const u16* a0p = (const u16*)(p.ws + OFF_YHY) + (long)(m0 + arow) * 512 + akc;
  const u16* a1p = urm + (long)(m0 + arow) * 6144 + akc;
  const u16* b0p = (const u16*)(p.ws + OFF_WTLIFT) + (long)(n0 + brow) * 512 + bkc;
  f32x16 tot[2], acc[2];
  tot[0] = zero16(); tot[1] = zero16(); acc[0] = zero16(); acc[1] = zero16();
  u32x4 ra0[2], rb0[2], ra1[2], rb1[2], ra2[2], rb2[2], ra3[2], rb3[2];
#define LS_LOAD(RA, RB, KI)                                                                         \
  {                                                                                                 \
    const int ki_ = ((KI) < 24) ? (KI) : 23;                                                        \
    const int seg_ = ki_ >> 3, kk_ = (ki_ & 7) * 64;                                                \
    const u16* ap_ = (seg_ == 0) ? (a0p + kk_) : (a1p + (seg_ == 1 ? 0 : 1536) + kk_);             \
    const long lda_ = (seg_ == 0) ? 512 : 6144;                                                     \
    const u16* bp_ = b0p + (long)seg_ * 1024 * 512 + kk_;                                           \
    RA[0] = *(const u32x4*)(ap_);                                                                   \
    RA[1] = *(const u32x4*)(ap_ + 64 * lda_);                                                       \
    RB[0] = *(const u32x4*)(bp_);                                                                   \
    RB[1] = *(const u32x4*)(bp_ + 32 * 512);                                                        \
  }
#define LS_STORE(RA, RB, STG)                                                                       \
  {                                                                                                 \
    u16* dA_ = sAall + (STG) * (128 * 72);                                                          \
    u16* dB_ = sBme + (STG) * (64 * 72);                                                            \
    *(u32x4*)(dA_ + arow * 72 + akc) = RA[0];                                                       \
    *(u32x4*)(dA_ + (arow + 64) * 72 + akc) = RA[1];                                                \
    *(u32x4*)(dB_ + brow * 72 + bkc) = RB[0];                                                       \
    *(u32x4*)(dB_ + (brow + 32) * 72 + bkc) = RB[1];                                                \
  }
#define LS_COMPUTE(STG, KS0)                                                                        \
  {                                                                                                 \
    const u16* sA_ = sAall + (STG) * (128 * 72);                                                    \
    const u16* sB_ = sBme + (STG) * (64 * 72);                                                      \
    __builtin_amdgcn_s_setprio(1);                                                                  \
    _Pragma("unroll") for (int ks = (KS0); ks < (KS0) + 2; ++ks) {                                  \
      bf16x8 af0 = *(const bf16x8*)(sA_ + (wm * 64 + r) * 72 + ks * 16 + h * 8);                    \
      bf16x8 af1 = *(const bf16x8*)(sA_ + (wm * 64 + 32 + r) * 72 + ks * 16 + h * 8);               \
      bf16x8 bf0 = *(const bf16x8*)(sB_ + (wn * 32 + r) * 72 + ks * 16 + h * 8);                    \
      acc[0] = mfma32(af0, bf0, acc[0]);                                                            \
      acc[1] = mfma32(af1, bf0, acc[1]);                                                            \
    }                                                                                               \
    __builtin_amdgcn_s_setprio(0);                                                                  \
  }
#define LS_STEP(K, RA, RB)                                                                          \
  {                                                                                                 \
    const int k = (K);                                                                              \
    const int cur = k & 1;                                                                          \
    if ((k & 7) == 0) {                                                                             \
      const int br = k >> 3;                                                                        \
      _Pragma("unroll") for (int i = 0; i < 2; ++i)                                                 \
        _Pragma("unroll") for (int g = 0; g < 16; ++g) {                                            \
          int m = m0 + wm * 64 + i * 32 + rowmap(g, h);                                             \
          int n = n0 + wn * 32 + r;                                                                 \
          gq[i][g] = urm[(long)m * 6144 + 3072 + br * 1024 + n];                                    \
        }                                                                                           \
    }                                                                                               \
    LS_COMPUTE(cur, 0)                                                                              \
    __builtin_amdgcn_sched_barrier(0);                                                              \
    if (k + 1 < 24) LS_STORE(RA, RB, cur ^ 1)                                                       \
    LS_LOAD(RA, RB, k + 5)                                                                          \
    __builtin_amdgcn_sched_barrier(0);                                                              \
    LS_COMPUTE(cur, 2)                                                                              \
    __syncthreads();                                                                                \
    if ((k & 7) == 7) {                                                                             \
      _Pragma("unroll") for (int i = 0; i < 2; ++i)                                                 \
        _Pragma("unroll") for (int g = 0; g < 16; ++g) {                                            \
          float gt = bf2f(gq[i][g]);                                                                \
          tot[i][g] += acc[i][g] / (1.f + __expf(-gt));                                             \
          acc[i][g] = 0.f;                                                                          \
        }                                                                                           \
    }                                                                                               \
  }
  LS_LOAD(ra0, rb0, 0)
  LS_LOAD(ra1, rb1, 1)
  LS_LOAD(ra2, rb2, 2)
  LS_LOAD(ra3, rb3, 3)
  __syncthreads();
  LS_STORE(ra0, rb0, 0)
  LS_LOAD(ra0, rb0, 4)
  __syncthreads();
  u16 gq[2][16];
#pragma unroll 1
  for (int kk = 0; kk < 24; kk += 4) {
    LS_STEP(kk + 0, ra1, rb1)
    LS_STEP(kk + 1, ra2, rb2)
    LS_STEP(kk + 2, ra3, rb3)
    LS_STEP(kk + 3, ra0, rb0)
  }
#undef LS_STEP
#undef LS_COMPUTE
#undef LS_STORE
#undef LS_LOAD
#pragma unroll
  for (int i = 0; i < 2; ++i)
#pragma unroll
    for (int g = 0; g < 16; ++g) {
      int R = wm * 64 + i * 32 + rowmap(g, h);
      int C = wn * 32 + r;
      sOut[R * 72 + C] = f2bf(tot[i][g]);
    }
  __syncthreads();
  for (int ch = ht; ch < 1024; ch += 256) {
    int row = ch >> 3, c8 = (ch & 7) * 8;
    *(u32x4*)((u16*)(p.ws + OFF_HBUF) + (long)(m0 + row) * 1024 + n0 + c8) = *(const u32x4*)(sOut + row * 72 + c8);
  }
}

__device__ __forceinline__ void resid_item(const Params& p, int l, int which, int tile, char* smem) {
  u16* sm = (u16*)smem;
  const int tid = otid(), lane = tid & 63, w = tid >> 6, wm = w & 1, wn = w >> 1, r = lane & 31, h = lane >> 5;
  int mt, nt;
  tile_swz(tile, 2, mt, nt);
  const int m0 = mt * 128, n0 = nt * 128;
  f32x16 acc[2][2];
  zero_acc(acc);
  if (which == 0) {
    gemm_tile<false, 2>(acc, (const u16*)(p.ws + OFF_HBUF) + (long)m0 * 1024, 1024,
                     (const u16*)(p.ws + OFF_WTOUT) + (long)n0 * 1024, 1024, 1024, sm);
  } else {
    gemm_tile<false, 2>(acc, (const u16*)(p.ws + OFF_URM) + (long)m0 * 2816, 2816,
                     (const u16*)(p.ws + OFF_WTFFO) + (long)n0 * 2816, 2816, 2816, sm);
  }
  const float* gate = mod_row(p, l, m0) + (which == 0 ? 2048 : 5120);
#pragma unroll
  for (int i = 0; i < 2; ++i)
#pragma unroll
    for (int j = 0; j < 2; ++j)
#pragma unroll
      for (int g = 0; g < 16; ++g) {
        int m = m0 + wm * 64 + i * 32 + rowmap(g, h);
        int n = n0 + wn * 64 + j * 32 + r;
        const float* xi = (which == 0) ? xin_row(p, l, m) : p.out + (long)m * 1024;
        p.out[(long)m * 1024 + n] = xi[n] + gate[n] * acc[i][j][g];
      }
}

__device__ __forceinline__ void ffn_in_item(const Params& p, int l, int tile, char* smem) {
  u16* sm = (u16*)smem;
  const int tid = otid(), lane = tid & 63, w = tid >> 6, wm = w & 1, wn = w >> 1, r = lane & 31, h = lane >> 5;
  int mt, nt;
  tile_swz(tile, 11, mt, nt);
  const int m0 = mt * 128, n0 = nt * 128;
  f32x16 acc[2][2];
  zero_acc(acc);
  gemm_tile<false, 2>(acc, (const u16*)(p.ws + OFF_HBUF) + (long)m0 * 1024, 1024,
                   (const u16*)(p.ws + OFF_WTFFI) + (long)n0 * 1024, 1024, 1024, sm);
#pragma unroll
  for (int i = 0; i < 2; ++i)
#pragma unroll
    for (int g = 0; g < 16; ++g) {
      int R = wm * 64 + i * 32 + rowmap(g, h);
      int C = wn * 32 + r;
      float gv = acc[i][0][g], uv = acc[i][1][g];
      sm[R * 72 + C] = f2bf(gv / (1.f + __expf(-gv)) * uv);
    }
  stage_store(sm, 72, 3, 1024, (u16*)(p.ws + OFF_URM) + (long)m0 * 2816 + nt * 64, 2816);
}

template <int L, int NTOK, bool PADDED>
__device__ __forceinline__ void hy_stage(const u16* __restrict__ src, float w0, float w1, float w2, float bb, u16* dst,
                                         int tid) {
#pragma unroll
  for (int it = 0; it < NTOK / 8 / 256; ++it) {
    const int q = (tid + 256 * it) * 8;
    const int s = q & (L - 1);
    const u32x4 v = *(const u32x4*)(src + q);
    const u16 lft = (s > 0) ? src[q - 1] : (u16)0;
    const u16 rgt = (s + 8 < L) ? src[q + 8] : (u16)0;
    float x[10];
    x[0] = bf2f(lft);
#pragma unroll
    for (int e = 0; e < 4; ++e) {
      x[1 + 2 * e] = __uint_as_float(v[e] << 16);
      x[2 + 2 * e] = __uint_as_float(v[e] & 0xffff0000u);
    }
    x[9] = bf2f(rgt);
    u32x4 o;
#pragma unroll
    for (int e = 0; e < 4; ++e) {
      float y0 = x[2 * e] * w0 + x[2 * e + 1] * w1 + x[2 * e + 2] * w2 + bb;
      float y1 = x[2 * e + 1] * w0 + x[2 * e + 2] * w1 + x[2 * e + 3] * w2 + bb;
      o[e] = pk2(y0, y1);
    }
    *(u32x4*)(dst + (PADDED ? ((q >> 6) * 72 + (q & 63)) : q)) = o;
  }
}

template <int NB>
__device__ __forceinline__ void hyena_item(const Params& p, int l, int c, char* smem) {
  constexpr int L = NB * 64;
  constexpr int NBATCH = (NB == 64) ? 4 : 32;
  constexpr int NQ = (NB == 64) ? 4 : 2;
  constexpr int NTOK = NBATCH * L;
  constexpr int HS = 2 * L + 32;
  const int tid = otid(), lane = tid & 63, w = tid >> 6, r = lane & 31, h = lane >> 5;
  u16* sZ = (u16*)smem;
  u16* sH = sZ + (NBATCH * NB + 1) * 72;
  const int seq0 = (NB == 64) ? NPR : 0;
  const u16* uh = (const u16*)(p.ws + OFF_UHYT);
  const u16* G = (const u16*)(p.ws + (NB == 64 ? OFF_FILT1 : OFF_FILT0));
  const float* P = (const float*)(p.ws + OFF_FPART) + (NB == 64 ? 0 : 128 * 2048);
  float as0 = 0.f, as1 = 0.f;
  {
    float* red = (float*)smem;
    __syncthreads();
    float v0 = 0.f, v1 = 0.f;
    for (int e = tid; e < NB * 8; e += 256) {
      const int ch = e >> 2, od = e & 3;
      const float pv = P[ch * 2048 + od * 512 + c];
      if (od < 2) v0 += pv; else v1 += pv;
    }
#pragma unroll
    for (int o = 32; o >= 1; o >>= 1) {
      v0 += shx(v0, lane, o);
      v1 += shx(v1, lane, o);
    }
    if (lane == 0) {
      red[w * 2] = v0;
      red[w * 2 + 1] = v1;
    }
    __syncthreads();
    as0 = red[0] + red[2] + red[4] + red[6];
    as1 = red[1] + red[3] + red[5] + red[7];
  }
  const float bias0 = p.hy_bias[(l * 2 + 0) * 512 + c], bias1 = p.hy_bias[(l * 2 + 1) * 512 + c];
  const int ah = w & 1, cgp = w >> 1;
  int zb[NQ], ii[NQ];
#pragma unroll
  for (int q = 0; q < NQ; ++q) {
    int col = (cgp + 2 * q) * 32 + r;
    zb[q] = (col / NB) * NB;
    ii[q] = col % NB;
  }
  const int dmin = (NB == 64) ? 32 * cgp - 63 : -3;
  const int dmax = (NB == 64) ? 32 * cgp + 31 : 3;
  __syncthreads();
  if (tid < 36) ((unsigned*)(sZ + NBATCH * NB * 72))[tid] = 0u;
#pragma unroll 1
  for (int ord = 0; ord < 2; ++ord) {
    if (ord == 0) {
      const int chn = c;
      const u16* src = uh + (long)chn * T_TOK + seq0;
      const float w0 = p.hy_conv_w[(l * 3 + 0) * 1536 + chn], w1 = p.hy_conv_w[(l * 3 + 1) * 1536 + chn],
                  w2 = p.hy_conv_w[(l * 3 + 2) * 1536 + chn], bb = p.hy_conv_b[l * 1536 + chn];
      hy_stage<L, NTOK, true>(src, w0, w1, w2, bb, sZ, tid);
    }
    {
      const u16* Gc = G + (long)(ord * 512 + c) * (2 * L);
#pragma unroll
      for (int it = 0; it < (2 * L / 8 + 255) / 256; ++it) {
        const int vi = tid + 256 * it;
        if (vi < 2 * L / 8) {
          u32x4 A4 = *(const u32x4*)(Gc + 8 * vi);
          const unsigned nxt = (8 * vi + 8 < 2 * L) ? (unsigned)Gc[8 * vi + 8] : 0u;
          if (vi == 0) A4[0] &= 0xffff0000u;
          u32x4 B4;
          B4[0] = (A4[0] >> 16) | (A4[1] << 16);
          B4[1] = (A4[1] >> 16) | (A4[2] << 16);
          B4[2] = (A4[2] >> 16) | (A4[3] << 16);
          B4[3] = (A4[3] >> 16) | (nxt << 16);
          *(u32x4*)(sH + 8 * vi) = A4;
          *(u32x4*)(sH + HS + 8 * vi) = B4;
        }
      }
      if (tid < 8) {
        sH[2 * L + tid] = 0;
        sH[HS + 2 * L + tid] = 0;
      }
    }
    __syncthreads();
    f32x16 acc[NQ];
#pragma unroll
    for (int q = 0; q < NQ; ++q) acc[q] = zero16();
    const LAS char* zbase = (const LAS char*)sZ;
    int zoff0[NQ];
#pragma unroll
    for (int q = 0; q < NQ; ++q) zoff0[q] = ((zb[q] + ii[q]) * 72 + h * 8) * 2;
    const int zzero = (NBATCH * NB * 72 + h * 8) * 2;
    const LAS char* hbase = (const LAS char*)sH + ((r & 1) * HS) * 2;
#define HY_PTRS(D, HP, ZP)                                                                          \
    {                                                                                               \
      const int e0_ = L - (64 * (D) + 32 * ah + r - 8 * h);                                          \
      HP = (const LAS unsigned*)(hbase + (e0_ & ~1) * 2);                                            \
      _Pragma("unroll") for (int q = 0; q < NQ; ++q) {                                               \
        const bool ok_ = (unsigned)(ii[q] - (D)) < (unsigned)NB;                                     \
        ZP[q] = zbase + (ok_ ? (zoff0[q] - (D) * 144) : zzero);                                      \
      }                                                                                             \
    }
#define HY_LOAD(TF, ZF, HP, ZP, KB)                                                                 \
    {                                                                                               \
      u32x4 tu_;                                                                                    \
      tu_[0] = HP[(KB) * 8 + 0];                                                                    \
      tu_[1] = HP[(KB) * 8 + 1];                                                                    \
      tu_[2] = HP[(KB) * 8 + 2];                                                                    \
      tu_[3] = HP[(KB) * 8 + 3];                                                                    \
      TF = (bf16x8)tu_;                                                                             \
      _Pragma("unroll") for (int q = 0; q < NQ; ++q) ZF[q] = *(const LAS bf16x8*)(ZP[q] + (KB) * 32); \
    }
#define HY_MMA(TF, ZF)                                                                              \
    {                                                                                               \
      _Pragma("unroll") for (int q = 0; q < NQ; ++q) acc[q] = mfma32(TF, ZF[q], acc[q]);             \
    }
    const LAS unsigned* hp;
    const LAS char* zp[NQ];
    const LAS unsigned* hpn;
    const LAS char* zpn[NQ];
    bf16x8 tA, tB, zA[NQ], zB[NQ];
    HY_PTRS(dmin, hp, zp)
    HY_LOAD(tA, zA, hp, zp, 0)
#pragma unroll 1
    for (int d = dmin; d <= dmax; ++d) {
      const int dn = (d < dmax) ? d + 1 : d;
      HY_PTRS(dn, hpn, zpn)
      HY_LOAD(tB, zB, hp, zp, 1)
      HY_MMA(tA, zA)
      __builtin_amdgcn_sched_barrier(0);
      HY_LOAD(tA, zA, hp, zp, 2)
      HY_MMA(tB, zB)
      __builtin_amdgcn_sched_barrier(0);
      HY_LOAD(tB, zB, hp, zp, 3)
      HY_MMA(tA, zA)
      __builtin_amdgcn_sched_barrier(0);
      HY_LOAD(tA, zA, hpn, zpn, 0)
      HY_MMA(tB, zB)
      __builtin_amdgcn_sched_barrier(0);
      hp = hpn;
#pragma unroll
      for (int q = 0; q < NQ; ++q) zp[q] = zpn[q];
    }
#undef HY_MMA
#undef HY_LOAD
#undef HY_PTRS
    __syncthreads();
    {
      const int chn = (ord + 1) * 512 + c;
      const u16* src = uh + (long)chn * T_TOK + seq0;
      const float w0 = p.hy_conv_w[(l * 3 + 0) * 1536 + chn], w1 = p.hy_conv_w[(l * 3 + 1) * 1536 + chn],
                  w2 = p.hy_conv_w[(l * 3 + 2) * 1536 + chn], bb = p.hy_conv_b[l * 1536 + chn];
      hy_stage<L, NTOK, false>(src, w0, w1, w2, bb, sH, tid);
    }
    __syncthreads();
    const float scl = 1.f / (ord == 0 ? as0 : as1);
    const float bia = ord == 0 ? bias0 : bias1;
    u16* yh = (u16*)(p.ws + OFF_YHY);
#pragma unroll
    for (int q = 0; q < NQ; ++q) {
      int blk = zb[q] + ii[q];
      asm volatile("" : "+v"(blk));
#pragma unroll
      for (int g = 0; g < 16; ++g) {
        const int a = 32 * ah + rowmap(g, h);
        const int zidx = blk * 72 + a;
        const int flat = blk * 64 + a;
        float y = acc[q][g] * scl;
        float zv = bf2f(sZ[zidx]);
        float xg = bf2f(sH[flat]);
        float res = xg * (y + zv * bia);
        if (ord == 0) sZ[zidx] = f2bf(res);
        else yh[(long)(seq0 + flat) * 512 + c] = f2bf(res);
        if ((g & 3) == 3) __builtin_amdgcn_sched_barrier(0);
      }
    }
    __syncthreads();
  }
}

template <int MODE>
__device__ __forceinline__ void attn_item(const Params& p, int l, int item, char* smem) {
  constexpr bool DA = (MODE & 1) != 0;
  constexpr bool SAMPLE = MODE >= 2;
  constexpr int NM = DA ? 2 : 1;
  const int tid = otid512(), lane = tid & 63, w = tid >> 6, r = lane & 31, h = lane >> 5;
  u16* sKV = (u16*)smem;
  constexpr int KVSTG = 64 * 72 + 64 * 68;
  float* sRpb = (float*)(sKV + 2 * KVSTG);
  u16* sQ = (u16*)(sRpb + 512);
  int b, qt, head;
  if (SAMPLE) {
    b = item >> 7;
    qt = (item >> 3) & 15;
    head = item & 7;
  } else {
    b = item >> 3;
    qt = 0;
    head = item & 7;
  }
  const int tokbase = SAMPLE ? NPR + b * 4096 : b * 256;
  const int tq = tokbase + qt * 256 + w * 32 + r;
  const int qcol = (DA ? 1536 : 0) + head * 64;
  u16* urm = (u16*)(p.ws + OFF_URM);
  int nlat, lat_tok0, rlo = 0;
  if (!SAMPLE) {
    nlat = 4;
    lat_tok0 = tokbase;
  } else if (DA) {
    nlat = 64;
    lat_tok0 = tokbase;
  } else {
    int r0a = clampi(4 * qt - 4, 0, 56), r0b = clampi(4 * qt - 1, 0, 56);
    rlo = r0a;
    nlat = r0b + 8 - r0a;
    lat_tok0 = tokbase + rlo * 64;
  }
  int nch = __builtin_amdgcn_readfirstlane(nlat + (SAMPLE ? 4 : 0));
  nlat = __builtin_amdgcn_readfirstlane(nlat);
  asm volatile("" : "+s"(nch));
  asm volatile("" : "+s"(nlat));
  const float LOG2E = 1.4426950408889634f;
  __syncthreads();
  if (MODE == 2) {
    const float* rp = p.na_rpb + ((long)l * 8 + head) * 465;
    for (int i = tid; i < 465; i += 512) sRpb[i] = rp[i] * LOG2E;
  }
#pragma unroll
  for (int i = 0; i < 4; ++i) {
    const int id = tid + 512 * i, row = id >> 3, c8 = (id & 7) * 8;
    *(u32x4*)(sQ + row * 72 + c8) = *(const u32x4*)(urm + (long)(tokbase + qt * 256 + row) * 6144 + qcol + c8);
  }
  const u16* sQw = sQ + (w * 32 + r) * 72 + h * 8;
  const float sc = (DA ? 0.17677669529663687f : 0.125f) * LOG2E;
  float mrun[NM], lsum[NM];
  f32x16 O[NM][2];
#pragma unroll
  for (int mp = 0; mp < NM; ++mp) {
    mrun[mp] = -1e30f;
    lsum[mp] = 0.f;
    O[mp][0] = zero16();
    O[mp][1] = zero16();
  }
  const int qrow = 4 * qt + (w >> 1);
  const int r0q = clampi(qrow - 4, 0, 56);
  const int qc = 32 * (w & 1) + r;
  const int c0 = clampi(qc - 8, 0, 48);

  const int key = tid >> 3, part = tid & 7;
  u32x4 k0;
  unsigned vq[4];
#define ATT_PREFETCH(CK)                                                                            \
  {                                                                                                 \
    const u16* ks_; const u16* vs_;                                                                 \
    if ((CK) < nlat) {                                                                              \
      ks_ = urm + (long)(lat_tok0 + (CK) * 64 + key) * 6144 + qcol + 512;                           \
      vs_ = ks_ + 512;                                                                              \
    } else {                                                                                        \
      const long off_ = (((long)b * 256 + ((CK) - nlat) * 64 + key) * 8 + head) * 64;               \
      ks_ = (const u16*)(p.ws + OFF_CTX) + (DA ? 2L : 0L) * 524288 + off_;                          \
      vs_ = ks_ + 524288;                                                                           \
    }                                                                                               \
    k0 = *(const u32x4*)(ks_ + part * 8);                                                           \
    _Pragma("unroll") for (int m = 0; m < 4; ++m) vq[m] = *(const unsigned*)(vs_ + 16 * m + 2 * part); \
  }
#define ATT_WRITE(STG, CK)                                                                          \
  {                                                                                                 \
    u16* sKw_ = sKV + (STG) * KVSTG;                                                                \
    u16* sVw_ = sKw_ + 64 * 72;                                                                     \
    *(u32x4*)(sKw_ + key * 72 + part * 8) = k0;                                                     \
    _Pragma("unroll") for (int m = 0; m < 4; ++m) {                                                 \
      const int dv_ = 16 * m + 2 * part;                                                            \
      sVw_[(dv_ + 0) * 68 + key] = (u16)(vq[m] & 0xffffu);                                          \
      sVw_[(dv_ + 1) * 68 + key] = (u16)(vq[m] >> 16);                                              \
    }                                                                                               \
  }
  ATT_PREFETCH(0)
  ATT_WRITE(0, 0)
  ATT_PREFETCH(1)
  __syncthreads();
#pragma unroll 1
  for (int ck = 0; ck < nch; ++ck) {
    const u16* sK = sKV + (ck & 1) * KVSTG;
    const u16* sVt = sK + 64 * 72;
    const bool latent = ck < nlat;
    const int kr = rlo + ck;
    bool active = true;
    if (MODE == 2 && latent) active = (kr >= r0q) && (kr < r0q + 8);
    if (active) {
#pragma unroll
      for (int mp = 0; mp < NM; ++mp) {
        f32x16 S[2];
        S[0] = zero16();
        S[1] = zero16();
#pragma unroll
        for (int st = 0; st < 2; ++st)
#pragma unroll
          for (int kk = 0; kk < (DA ? 2 : 4); ++kk) {
            const int ks = DA ? (2 * mp + kk) : kk;
            bf16x8 kf = *(const bf16x8*)(sK + (st * 32 + r) * 72 + ks * 16 + h * 8);
            bf16x8 qfr = *(const bf16x8*)(sQw + ks * 16);
            S[st] = mfma32(kf, qfr, S[st]);
          }
        const bool masked = (MODE == 2) && latent;
        float mx = -INFINITY;
        if (masked) {
#pragma unroll
          for (int st = 0; st < 2; ++st)
#pragma unroll
            for (int g = 0; g < 16; ++g) {
              float t = S[st][g] * sc;
              int kc = st * 32 + rowmap(g, h);
              bool ok = (kc >= c0) && (kc < c0 + 16);
              int dc = clampi(kc - qc, -15, 15);
              float bias = sRpb[(kr - qrow + 7) * 31 + dc + 15];
              t = ok ? t + bias : -INFINITY;
              S[st][g] = t;
              mx = fmaxf(mx, t);
            }
          mx = fmaxf(mx, shx(mx, lane, 32));
        } else {
#pragma unroll
          for (int st = 0; st < 2; ++st)
#pragma unroll
            for (int g = 0; g < 16; ++g) mx = fmaxf(mx, S[st][g]);
          mx = fmaxf(mx, shx(mx, lane, 32)) * sc;
        }
        const float mold = mrun[mp];
        const bool upd = mx > mold + 8.f;
        const float mnew = upd ? mx : mold;
        if (__builtin_amdgcn_ballot_w64(upd) != 0ull) {
          const float alpha = __builtin_amdgcn_exp2f(mold - mnew);
          mrun[mp] = mnew;
          lsum[mp] *= alpha;
#pragma unroll
          for (int g = 0; g < 16; ++g) {
            O[mp][0][g] *= alpha;
            O[mp][1][g] *= alpha;
          }
        }
        float ps = 0.f;
        if (masked) {
#pragma unroll
          for (int st = 0; st < 2; ++st)
#pragma unroll
            for (int g = 0; g < 16; ++g) {
              float pv = __builtin_amdgcn_exp2f(S[st][g] - mnew);
              S[st][g] = pv;
              ps += pv;
            }
        } else {
#pragma unroll
          for (int st = 0; st < 2; ++st)
#pragma unroll
            for (int g = 0; g < 16; ++g) {
              float pv = __builtin_amdgcn_exp2f(__builtin_fmaf(S[st][g], sc, -mnew));
              S[st][g] = pv;
              ps += pv;
            }
        }
        lsum[mp] += ps;
#pragma unroll
        for (int st = 0; st < 2; ++st)
#pragma unroll
          for (int s2 = 0; s2 < 2; ++s2) {
            u32x4 pu;
#pragma unroll
            for (int e = 0; e < 4; ++e) pu[e] = pk2(S[st][8 * s2 + 2 * e], S[st][8 * s2 + 2 * e + 1]);
            const bf16x8 pf = (bf16x8)pu;
#pragma unroll
            for (int dvt = 0; dvt < 2; ++dvt) {
              const u16* vp = sVt + (dvt * 32 + r) * 68 + st * 32 + s2 * 16 + 4 * h;
              u32x2 lo = *(const u32x2*)vp;
              u32x2 hi = *(const u32x2*)(vp + 8);
              u32x4 vv;
              vv[0] = lo[0]; vv[1] = lo[1]; vv[2] = hi[0]; vv[3] = hi[1];
              O[mp][dvt] = mfma32((bf16x8)vv, pf, O[mp][dvt]);
            }
          }
      }
    }
    if (ck + 1 < nch) ATT_WRITE((ck + 1) & 1, ck + 1)
    if (ck + 2 < nch) ATT_PREFETCH(ck + 2)
    __syncthreads();
  }
#undef ATT_WRITE
#undef ATT_PREFETCH
  float inv[NM];
#pragma unroll
  for (int mp = 0; mp < NM; ++mp) {
    float lt = lsum[mp] + shx(lsum[mp], lane, 32);
    inv[mp] = 1.f / lt;
  }
  u16* dst = urm + (long)tq * 6144 + qcol;
  if (!DA) {
#pragma unroll
    for (int dvt = 0; dvt < 2; ++dvt)
#pragma unroll
      for (int g4 = 0; g4 < 4; ++g4) {
        u32x2 o2;
        o2[0] = pk2(O[0][dvt][4 * g4] * inv[0], O[0][dvt][4 * g4 + 1] * inv[0]);
        o2[1] = pk2(O[0][dvt][4 * g4 + 2] * inv[0], O[0][dvt][4 * g4 + 3] * inv[0]);
        *(u32x2*)(dst + dvt * 32 + 8 * g4 + 4 * h) = o2;
      }
  } else {
    const float lam = ((const float*)(p.ws + OFF_LAM))[l];
    const float one_m_li = ((const float*)(p.ws + OFF_LAM))[4 + l];
    float ss = 0.f;
#pragma unroll
    for (int dvt = 0; dvt < 2; ++dvt)
#pragma unroll
      for (int g = 0; g < 16; ++g) {
        float o = O[0][dvt][g] * inv[0] - lam * (O[NM - 1][dvt][g] * inv[NM - 1]);
        O[0][dvt][g] = o;
        ss += o * o;
      }
    ss += shx(ss, lane, 32);
    const float rn = rsqrtf(ss * (1.f / 64.f) + 1e-6f) * one_m_li;
    const float* sg = p.da_subln + l * 64;
#pragma unroll
    for (int dvt = 0; dvt < 2; ++dvt)
#pragma unroll
      for (int g4 = 0; g4 < 4; ++g4) {
        const int dv = dvt * 32 + 8 * g4 + 4 * h;
        float4 gg = *(const float4*)(sg + dv);
        u32x2 o2;
        o2[0] = pk2(O[0][dvt][4 * g4] * rn * gg.x, O[0][dvt][4 * g4 + 1] * rn * gg.y);
        o2[1] = pk2(O[0][dvt][4 * g4 + 2] * rn * gg.z, O[0][dvt][4 * g4 + 3] * rn * gg.w);
        *(u32x2*)(dst + dv) = o2;
      }
  }
}


#define XB_TMO      128
#define XB_XCNT(j)  (256  + 64 * (j))
#define XB_XSUB(j)  (1280 + 64 * (j))
#define XB_XGEN(j)  (2304 + 64 * (j))
#define XB_TOP      3328
#define XB_TOPGEN   3392
#define XCD_BAR_WORDS 3456
#define XB_SPIN_CAP (1u << 22)
__device__ __forceinline__ unsigned xb_ld(unsigned* p) { return __hip_atomic_load(p, __ATOMIC_RELAXED, __HIP_MEMORY_SCOPE_AGENT); }
__device__ __forceinline__ unsigned xb_add(unsigned* p, unsigned v) { return __hip_atomic_fetch_add(p, v, __ATOMIC_RELAXED, __HIP_MEMORY_SCOPE_AGENT); }
__device__ __forceinline__ unsigned xb_xcc_id() { return (unsigned)__builtin_amdgcn_s_getreg((3 << 11) | 20) & 0xFu; }
#define XB_SPIN(cond, bar) do { unsigned _sp = 0; while (cond) { __builtin_amdgcn_s_sleep(1); \
    if ((++_sp & 255u) == 0u) { if (xb_ld(&(bar)[XB_TMO])) break; if (_sp > XB_SPIN_CAP) { atomicAdd(&(bar)[XB_TMO], 1u); break; } } } } while (0)
struct XcdBarrier { unsigned* bar; unsigned x; volatile LAS unsigned* st; };
__device__ __forceinline__ XcdBarrier xcd_barrier_post(unsigned* bar, volatile LAS unsigned* st) {
  XcdBarrier b; b.bar = bar; b.x = xb_xcc_id(); b.st = st;
  if (threadIdx.x == 0) (void)xb_add(&bar[XB_XCNT(b.x)], 1u);
  return b;
}
__device__ __forceinline__ void xcd_barrier_complete(unsigned* bar, unsigned x, unsigned& nloc, unsigned& nx) {
  const unsigned G = gridDim.x * gridDim.y * gridDim.z;
  unsigned sum, cnt, mine, sp = 0u;
  for (;;) {
    sum = 0u; cnt = 0u; mine = 0u;
#pragma unroll
    for (unsigned j = 0; j < 16; ++j) { const unsigned c = xb_ld(&bar[XB_XCNT(j)]); sum += c; cnt += (c > 0u) ? 1u : 0u; mine = (j == x) ? c : mine; }
    if (sum == G) break;
    __builtin_amdgcn_s_sleep(1);
    if ((++sp & 255u) == 0u) { if (xb_ld(&bar[XB_TMO])) break; if (sp > XB_SPIN_CAP) { atomicAdd(&bar[XB_TMO], 1u); break; } }
  }
  nloc = mine > 0u ? mine : 1u; nx = cnt > 0u ? cnt : 1u;
}
__device__ __forceinline__ void xcd_barrier(const XcdBarrier& b) {
  asm volatile("s_waitcnt vmcnt(0)" ::: "memory");
  __syncthreads();
  if (threadIdx.x == 0) {
    unsigned* bar = b.bar;
    __builtin_amdgcn_s_waitcnt(0);
    unsigned nloc = b.st[0], nx = b.st[1];
    if (nloc == 0u) { xcd_barrier_complete(bar, b.x, nloc, nx); b.st[0] = nloc; b.st[1] = nx; }
    const unsigned old = xb_add(&bar[XB_XSUB(b.x)], 1u);
    const unsigned gen = old / nloc;
    if (old + 1u == (gen + 1u) * nloc) {
      __builtin_amdgcn_fence(__ATOMIC_RELEASE, "agent");
      asm volatile("s_waitcnt vmcnt(0)" ::: "memory");
      const unsigned og = xb_add(&bar[XB_TOP], 1u);
      const unsigned tg = og / nx;
      if (og + 1u == (tg + 1u) * nx) xb_add(&bar[XB_TOPGEN], 1u);
      else XB_SPIN(xb_ld(&bar[XB_TOPGEN]) == tg, bar);
      __builtin_amdgcn_fence(__ATOMIC_ACQUIRE, "agent");
      xb_add(&bar[XB_XGEN(b.x)], 1u);
      asm volatile("s_waitcnt vmcnt(0)" ::: "memory");
    } else {
      XB_SPIN(xb_ld(&bar[XB_XGEN(b.x)]) == gen, bar);
      __builtin_amdgcn_fence(__ATOMIC_ACQUIRE, "agent");
      asm volatile("s_waitcnt vmcnt(0)" ::: "memory");
    }
  }
  __syncthreads();
}

__global__ void __launch_bounds__(512, 2) trunk_megakernel(Params p) {
  __shared__ __attribute__((aligned(16))) char smem[SMEM_BYTES];
  __shared__ uint4 xb_words;
  cg::grid_group grid = cg::this_grid();
  const int nb = gridDim.x, bid = blockIdx.x;
  const int half = __builtin_amdgcn_readfirstlane((int)(threadIdx.x >> 8));
  char* hsm = smem + half * HALF_BYTES;
  LAS char* lsm = (LAS char*)smem;
  if (threadIdx.x == 0) xb_words = make_uint4(0u, 0u, 0u, 0u);
  __syncthreads();
  XcdBarrier xb = xcd_barrier_post((unsigned*)(p.ws + OFF_BAR), (volatile LAS unsigned*)&xb_words);

  for (int it = bid; it < 385; it += nb) phase0_item(p, 2 * it + half, hsm);
  grid.sync();

  for (int l = 0; l < 4; ++l) {
    for (int it = bid; it < 544; it += nb) {
      const int item = 2 * it + half;
      filter_item(p, l, item >> 3, item & 7, hsm);
    }
    if (nb == 256) {
      const int q0 = (bid >= 32) ? (bid - 32) : (3968 + bid);
      const int qs = (bid >= 32) ? 224 : 32;
      const int qe = (bid >= 32) ? 3968 : 4128;
      for (int q = q0; q < qe; q += qs) {
        const int item = 2 * q + half;
        if (item < 4672) convert_item(p, l, item, hsm);
        else if (item < 4672 + 3072) norm_item(p, l, 0, item - 4672);
        else ctx_convert_item(p, l, item - 4672 - 3072);
      }
    } else {
      for (int q = bid; q < 4128; q += nb) {
        const int item = 2 * q + half;
        if (item < 4672) convert_item(p, l, item, hsm);
        else if (item < 4672 + 3072) norm_item(p, l, 0, item - 4672);
        else ctx_convert_item(p, l, item - 4672 - 3072);
      }
    }
    xcd_barrier(xb);
    for (int it = bid; it < 96 * 30; it += nb) gemm_in_fast(p, l, it, lsm);
    xcd_barrier(xb);
    for (int it = bid; it < 256 + 512 + 512 + 256 + 256 + 256; it += nb) {
      if (it < 256) hyena_item<64>(p, l, 2 * it + half, hsm);
      else if (it < 768) attn_item<3>(p, l, it - 256, smem);
      else if (it < 1280) attn_item<2>(p, l, it - 768, smem);
      else if (it < 1536) attn_item<0>(p, l, it - 1280, smem);
      else if (it < 1792) attn_item<1>(p, l, it - 1536, smem);
      else hyena_item<4>(p, l, 2 * (it - 1792) + half, hsm);
    }
    xcd_barrier(xb);
    for (int it = bid; it < 192 * 8; it += nb) lift_pair_item(p, l, it, smem);
    xcd_barrier(xb);
    for (int it = bid; it < 96 * 4; it += nb) resid_fast(p, l, 0, it, lsm);
    xcd_barrier(xb);
    for (int it = bid; it < 1536; it += nb) norm_item(p, l, 1, 2 * it + half);
    xcd_barrier(xb);
    for (int it = bid; it < 96 * 22; it += nb) ffn_in_fast(p, l, it, lsm);
    xcd_barrier(xb);
    for (int it = bid; it < 96 * 4; it += nb) resid_fast(p, l, 1, it, lsm);
    xcd_barrier(xb);
  }
  for (int it = bid; it < 3072; it += nb) final_norm_item(p, 2 * it + half);
}

extern "C" void kernel_launch(void* const* d_in, const int* in_sizes, int n_in, void* d_out, int out_size, void* d_ws,
                              size_t ws_size, hipStream_t stream) {
  static int grid_blocks = 0;
  if (!grid_blocks) {
    int dev = 0, cus = 0, per_cu = 0;
    hipGetDevice(&dev);
    hipDeviceGetAttribute(&cus, hipDeviceAttributeMultiprocessorCount, dev);
    hipOccupancyMaxActiveBlocksPerMultiprocessor(&per_cu, trunk_megakernel, 512, 0);
    if (per_cu > 1) per_cu = 1;
    if (per_cu < 1) per_cu = 1;
    grid_blocks = cus * per_cu;
  }
  Params p{};
  const float** pp = (const float**)&p;
  for (int i = 0; i < 30; ++i) pp[i] = (const float*)d_in[i];
  p.out = (float*)d_out;
  p.ws = (char*)d_ws;
  if (ws_size < (size_t)WS_NEED) fprintf(stderr, "workspace too small: %zu < %ld\n", ws_size, (long)WS_NEED);
  hipMemsetAsync((char*)d_ws + OFF_BAR, 0, XCD_BAR_WORDS * 4, stream);
  void* args[] = {&p};
  hipError_t e = hipLaunchCooperativeKernel((void*)trunk_megakernel, dim3(grid_blocks), dim3(512), args, 0, stream);
  if (e != hipSuccess) fprintf(stderr, "cooperative launch failed: %s (grid %d)\n", hipGetErrorString(e), grid_blocks);
}
```

```cpp
#include <hip/hip_runtime.h>
#include <hip/hip_cooperative_groups.h>
#include <stdio.h>
namespace cg = cooperative_groups;

#define LAS __attribute__((address_space(3)))
typedef unsigned short u16;
using bf16x8 = __attribute__((ext_vector_type(8))) short;
using f32x16 = __attribute__((ext_vector_type(16))) float;
using u32x4 = __attribute__((ext_vector_type(4))) unsigned;
using u32x2 = __attribute__((ext_vector_type(2))) unsigned;

struct Params {
  const float *x_prompt, *x_sample, *cna_k, *cna_v, *cda_k, *cda_v, *c, *c_ctx, *w_ada, *b_ada, *norm_mix,
      *norm_ffn, *w_in, *hy_conv_w, *hy_conv_b, *fw1, *fb1, *fw2, *fb2, *fw3, *ffreq, *hy_bias, *na_rpb,
      *da_lambda, *da_subln, *w_lift, *w_out, *w_ffn_in, *w_ffn_out, *norm_final;
  float* out;
  char* ws;
};

constexpr int T_TOK = 24576;
constexpr int NPR = 8192;
constexpr long OFF_URM = 0;
constexpr long OFF_UHYT = OFF_URM + 24576L * 6144 * 2;
constexpr long OFF_YHY = OFF_UHYT + 1536L * 24576 * 2;
constexpr long OFF_HBUF = OFF_YHY + 24576L * 512 * 2;
constexpr long OFF_WTIN = OFF_HBUF + 24576L * 1024 * 2;
constexpr long OFF_WTLIFT = OFF_WTIN + 7680L * 1024 * 2;
constexpr long OFF_WTOUT = OFF_WTLIFT + 3L * 1024 * 512 * 2;
constexpr long OFF_WTFFI = OFF_WTOUT + 1024L * 1024 * 2;
constexpr long OFF_WTFFO = OFF_WTFFI + 5632L * 1024 * 2;
constexpr long OFF_FILT1 = OFF_WTFFO + 1024L * 2816 * 2;
constexpr long OFF_FILT0 = OFF_FILT1 + 2L * 512 * 8192 * 2;
constexpr long OFF_FPART = OFF_FILT0 + 2L * 512 * 512 * 2;
constexpr long OFF_MOD = OFF_FPART + 136L * 2048 * 4;
constexpr long OFF_ROPE = OFF_MOD + 4L * 5 * 6144 * 4;
constexpr long OFF_LAM = OFF_ROPE + 4096;
constexpr long OFF_BAR = OFF_LAM + 256;
constexpr long WS_NEED = OFF_BAR + 16384;

constexpr long OUT_NAK = 24576L * 1024;
constexpr long OUT_SZ = 32L * 4 * 256 * 512;

constexpr int HALF_BYTES = 73728;
constexpr int SMEM_BYTES = 2 * HALF_BYTES;

typedef __attribute__((ext_vector_type(2))) __bf16 bf2_t;
typedef __attribute__((ext_vector_type(2))) float f2_t;
__device__ __forceinline__ unsigned pk2(float a, float b) {
  f2_t v = {a, b};
  return __builtin_bit_cast(unsigned, __builtin_convertvector(v, bf2_t));
}
__device__ __forceinline__ u16 f2bf(float f) { return (u16)(pk2(f, 0.f) & 0xffffu); }
__device__ __forceinline__ float bf2f(u16 b) { return __uint_as_float(((unsigned)b) << 16); }
__device__ __forceinline__ f32x16 mfma32(bf16x8 a, bf16x8 b, f32x16 c) {
  return __builtin_amdgcn_mfma_f32_32x32x16_bf16(a, b, c, 0, 0, 0);
}
__device__ __forceinline__ f32x16 zero16() {
  f32x16 z;
#pragma unroll
  for (int i = 0; i < 16; ++i) z[i] = 0.f;
  return z;
}
__device__ __forceinline__ int otid512() {
  int t = threadIdx.x;
  asm volatile("" : "+v"(t));
  return t;
}
__device__ __forceinline__ int otid() { return otid512() & 255; }
__device__ __forceinline__ float shx(float v, int lane, int mask) {
  return __int_as_float(__builtin_amdgcn_ds_bpermute((lane ^ mask) << 2, __float_as_int(v)));
}
__device__ __forceinline__ int clampi(int v, int lo, int hi) { return v < lo ? lo : (v > hi ? hi : v); }
__device__ __forceinline__ int rowmap(int g, int h) { return (g & 3) + 8 * (g >> 2) + 4 * h; }

constexpr int GEMM_STAGE = 2 * 128 * 72;
#define GEMM_LOAD(RA, RB, KOFF)                                                                      \
  {                                                                                                 \
    _Pragma("unroll") for (int i = 0; i < 4; ++i) RA[i] = *(const u32x4*)(ap + (long)(32 * i) * lda + (KOFF));        \
    _Pragma("unroll") for (int i = 0; i < 2 * NJ; ++i) RB[i] = *(const u32x4*)(bp + (long)(32 * i) * ldb + (KOFF));   \
  }
#define GEMM_STORE(RA, RB, STG)                                                                     \
  {                                                                                                 \
    u16* nA_ = sm + (STG) * GEMM_STAGE;                                                             \
    _Pragma("unroll") for (int i = 0; i < 4; ++i) *(u32x4*)(nA_ + (lrow + 32 * i) * 72 + lkc) = RA[i];               \
    _Pragma("unroll") for (int i = 0; i < 2 * NJ; ++i) *(u32x4*)(nA_ + 128 * 72 + (lrow + 32 * i) * 72 + lkc) = RB[i]; \
  }
#define GEMM_COMPUTE_HALF(STG, KS0)                                                                 \
  {                                                                                                 \
    const u16* sA = sm + (STG) * GEMM_STAGE;                                                        \
    const u16* sB = sA + 128 * 72;                                                                  \
    __builtin_amdgcn_s_setprio(1);                                                                  \
    _Pragma("unroll") for (int ks = (KS0); ks < (KS0) + 2; ++ks) {                                  \
      bf16x8 af[2], bfr[NJ];                                                                        \
      _Pragma("unroll") for (int i = 0; i < 2; ++i) af[i] = *(const bf16x8*)(sA + (wm * 64 + i * 32 + r) * 72 + ks * 16 + h * 8); \
      _Pragma("unroll") for (int j = 0; j < NJ; ++j) bfr[j] = *(const bf16x8*)(sB + (wn * 32 * NJ + j * 32 + r) * 72 + ks * 16 + h * 8); \
      _Pragma("unroll") for (int i = 0; i < 2; ++i)                                                 \
        _Pragma("unroll") for (int j = 0; j < NJ; ++j)                                              \
          acc[i][j] = SWAP ? mfma32(bfr[j], af[i], acc[i][j]) : mfma32(af[i], bfr[j], acc[i][j]);   \
    }                                                                                               \
    __builtin_amdgcn_s_setprio(0);                                                                  \
  }

template <bool SWAP, int NJ>
__device__ __forceinline__ void gemm_tile(f32x16 (&acc)[2][NJ], const u16* __restrict__ A, long lda,
                                          const u16* __restrict__ B, long ldb, int K, u16* sm) {
  const int tid = otid(), lane = tid & 63, w = tid >> 6, wm = w & 1, wn = w >> 1, r = lane & 31, h = lane >> 5;
  const int lrow = tid >> 3, lkc = (tid & 7) * 8;
  const u16* ap = A + (long)lrow * lda + lkc;
  const u16* bp = B + (long)lrow * ldb + lkc;
  const int nk = K >> 6;
  u32x4 ra0[4], rb0[2 * NJ];
  GEMM_LOAD(ra0, rb0, 0)
  __syncthreads();
  GEMM_STORE(ra0, rb0, 0)
  GEMM_LOAD(ra0, rb0, 64)
  __syncthreads();
#pragma unroll 1
  for (int k = 0; k < nk; ++k) {
    const int cur = k & 1;
    GEMM_COMPUTE_HALF(cur, 0)
    __builtin_amdgcn_sched_barrier(0);
    if (k + 1 < nk) GEMM_STORE(ra0, rb0, cur ^ 1)
    if (k + 2 < nk) GEMM_LOAD(ra0, rb0, (k + 2) * 64)
    __builtin_amdgcn_sched_barrier(0);
    GEMM_COMPUTE_HALF(cur, 2)
    __syncthreads();
  }
}

__device__ __forceinline__ void stage_store(const u16* sC, int lds_ld, int cpr_log2, int nchunks, u16* dst, long ld) {
  const int tid = otid();
  __syncthreads();
  for (int ch = tid; ch < nchunks; ch += 256) {
    int row = ch >> cpr_log2, c8 = (ch & ((1 << cpr_log2) - 1)) * 8;
    *(u32x4*)(dst + (long)row * ld + c8) = *(const u32x4*)(sC + row * lds_ld + c8);
  }
}

__device__ __forceinline__ void zero_acc(f32x16 (&acc)[2][2]) {
#pragma unroll
  for (int i = 0; i < 2; ++i)
#pragma unroll
    for (int j = 0; j < 2; ++j) acc[i][j] = zero16();
}

__device__ __forceinline__ const float* xin_row(const Params& p, int l, int row) {
  if (l == 0) return row < NPR ? p.x_prompt + (long)row * 1024 : p.x_sample + (long)(row - NPR) * 1024;
  return p.out + (long)row * 1024;
}
__device__ __forceinline__ const float* mod_row(const Params& p, int l, int row) {
  int mi = row < NPR ? 0 : 1 + ((row - NPR) >> 12);
  return (const float*)(p.ws + OFF_MOD) + (long)(l * 5 + mi) * 6144;
}

__device__ __forceinline__ void phase0_item(const Params& p, int it, char* smem) {
  const int tid = otid();
  __syncthreads();
  if (it < 768) {
    float* s = (float*)smem;
    float* red = s + 5120;
    for (int i = tid; i < 5120; i += 256) {
      int v = i >> 10, k = i & 1023;
      float x = v == 0 ? p.c_ctx[k] : p.c[(v - 1) * 1024 + k];
      s[i] = x / (1.f + expf(-x));
    }
    __syncthreads();
    const int l = it / 192, grp = it % 192, col = tid & 31, kg = tid >> 5;
    const int n = grp * 32 + col;
    const float* W = p.w_ada + (long)l * 1024 * 6144 + n;
    float a0 = 0, a1 = 0, a2 = 0, a3 = 0, a4 = 0;
#pragma unroll 16
    for (int kk = 0; kk < 128; ++kk) {
      const int k = kg * 128 + kk;
      float wv = W[(long)k * 6144];
      a0 += s[k] * wv;
      a1 += s[1024 + k] * wv;
      a2 += s[2048 + k] * wv;
      a3 += s[3072 + k] * wv;
      a4 += s[4096 + k] * wv;
    }
    red[(kg * 5 + 0) * 32 + col] = a0;
    red[(kg * 5 + 1) * 32 + col] = a1;
    red[(kg * 5 + 2) * 32 + col] = a2;
    red[(kg * 5 + 3) * 32 + col] = a3;
    red[(kg * 5 + 4) * 32 + col] = a4;
    __syncthreads();
    if (tid < 160) {
      const int v = tid >> 5, cc = tid & 31;
      float t = p.b_ada[l * 6144 + grp * 32 + cc];
#pragma unroll
      for (int g = 0; g < 8; ++g) t += red[(g * 5 + v) * 32 + cc];
      ((float*)(p.ws + OFF_MOD))[(long)(l * 5 + v) * 6144 + grp * 32 + cc] = t;
    }
  } else if (it == 768) {
    float* rc = (float*)(p.ws + OFF_ROPE);
    for (int i = tid; i < 512; i += 256) {
      int pos = i >> 3, f = i & 7;
      float inv = powf(10000.f, -(float)f / 8.f);
      float ang = (float)pos * inv;
      rc[i] = cosf(ang);
      rc[512 + i] = sinf(ang);
    }
    if (tid < 4) {
      const float* lp = p.da_lambda + tid * 128;
      float s01 = 0, s23 = 0;
      for (int i = 0; i < 32; ++i) {
        s01 += lp[i] * lp[32 + i];
        s23 += lp[64 + i] * lp[96 + i];
      }
      float lam_init = 0.8f - 0.6f * expf(-0.3f * (float)tid);
      ((float*)(p.ws + OFF_LAM))[tid] = expf(s01) - expf(s23) + lam_init;
      ((float*)(p.ws + OFF_LAM))[4 + tid] = 1.f - lam_init;
    }
  }
}

__device__ __forceinline__ void norm_item(const Params& p, int l, int which, int item) {
  const int tid = otid(), lane = tid & 63, w = tid >> 6;
  const int row0 = item * 8 + w * 2;
  const float* g = (which == 0 ? p.norm_mix : p.norm_ffn) + l * 1024;
  float4 v[2][4];
  float ss[2];
#pragma unroll
  for (int rr = 0; rr < 2; ++rr) {
    const float* x = (which == 0) ? xin_row(p, l, row0 + rr) : p.out + (long)(row0 + rr) * 1024;
#pragma unroll
    for (int i = 0; i < 4; ++i) v[rr][i] = *(const float4*)(x + lane * 4 + 256 * i);
  }
#pragma unroll
  for (int rr = 0; rr < 2; ++rr) {
    float a = 0.f;
#pragma unroll
    for (int i = 0; i < 4; ++i)
      a += v[rr][i].x * v[rr][i].x + v[rr][i].y * v[rr][i].y + v[rr][i].z * v[rr][i].z + v[rr][i].w * v[rr][i].w;
#pragma unroll
    for (int o = 32; o >= 1; o >>= 1) a += shx(a, lane, o);
    ss[rr] = rsqrtf(a * (1.f / 1024.f) + 1e-6f);
  }
  const float* mp = mod_row(p, l, row0) + which * 3072;
#pragma unroll
  for (int i = 0; i < 4; ++i) {
    int c = lane * 4 + 256 * i;
    float4 gg = *(const float4*)(g + c);
    float4 sh = *(const float4*)(mp + c);
    float4 sc = *(const float4*)(mp + 1024 + c);
#pragma unroll
    for (int rr = 0; rr < 2; ++rr) {
      const float rs = ss[rr];
      float y0 = v[rr][i].x * rs * gg.x * (1.f + sc.x) + sh.x;
      float y1 = v[rr][i].y * rs * gg.y * (1.f + sc.y) + sh.y;
      float y2 = v[rr][i].z * rs * gg.z * (1.f + sc.z) + sh.z;
      float y3 = v[rr][i].w * rs * gg.w * (1.f + sc.w) + sh.w;
      u32x2 o2;
      o2[0] = pk2(y0, y1);
      o2[1] = pk2(y2, y3);
      *(u32x2*)((u16*)(p.ws + OFF_HBUF) + (long)(row0 + rr) * 1024 + c) = o2;
    }
  }
}

__device__ __forceinline__ void final_norm_item(const Params& p, int item) {
  const int tid = otid(), lane = tid & 63, w = tid >> 6;
  const int row = item * 4 + w;
  float* x = p.out + (long)row * 1024;
  float4 v[4];
  float ss = 0;
#pragma unroll
  for (int i = 0; i < 4; ++i) {
    v[i] = *(const float4*)(x + lane * 4 + 256 * i);
    ss += v[i].x * v[i].x + v[i].y * v[i].y + v[i].z * v[i].z + v[i].w * v[i].w;
  }
#pragma unroll
  for (int o = 32; o >= 1; o >>= 1) ss += shx(ss, lane, o);
  const float rs = rsqrtf(ss * (1.f / 1024.f) + 1e-6f);
#pragma unroll
  for (int i = 0; i < 4; ++i) {
    int c = lane * 4 + 256 * i;
    float4 gg = *(const float4*)(p.norm_final + c);
    float4 o;
    o.x = v[i].x * rs * gg.x;
    o.y = v[i].y * rs * gg.y;
    o.z = v[i].z * rs * gg.z;
    o.w = v[i].w * rs * gg.w;
    *(float4*)(x + c) = o;
  }
}

__device__ __forceinline__ int colmap(int n, int mode) {
  if (mode == 0) return n;
  return ((n >> 4) & 1) * 2816 + (n >> 5) * 16 + (n & 15);
}
__device__ __forceinline__ void conv_tile(const float* __restrict__ src, int ldsrc, u16* __restrict__ dst, int K, int k0, int n0,
                          int mode, char* smem) {
  float* tile = (float*)smem;
  const int tid = otid();
  __syncthreads();
#pragma unroll
  for (int i = 0; i < 4; ++i) {
    int kk = (tid >> 4) + 16 * i, nn = (tid & 15) * 4;
    int sc = colmap(n0 + nn, mode);
    float4 v = *(const float4*)(src + (long)(k0 + kk) * ldsrc + sc);
    tile[kk * 65 + nn] = v.x;
    tile[kk * 65 + nn + 1] = v.y;
    tile[kk * 65 + nn + 2] = v.z;
    tile[kk * 65 + nn + 3] = v.w;
  }
  __syncthreads();
  const int n = tid >> 2, kc = (tid & 3) * 16;
  u32x4 o0, o1;
#pragma unroll
  for (int e = 0; e < 4; ++e) {
    o0[e] = pk2(tile[(kc + 2 * e) * 65 + n], tile[(kc + 2 * e + 1) * 65 + n]);
    o1[e] = pk2(tile[(kc + 8 + 2 * e) * 65 + n], tile[(kc + 8 + 2 * e + 1) * 65 + n]);
  }
  u16* d = dst + (long)(n0 + n) * K + k0 + kc;
  *(u32x4*)d = o0;
  *(u32x4*)(d + 8) = o1;
}

__device__ __forceinline__ void convert_item(const Params& p, int l, int it, char* smem) {
  if (it < 1920) {
    int kt = it / 120, nt = it % 120;
    conv_tile(p.w_in + (long)l * 1024 * 7680, 7680, (u16*)(p.ws + OFF_WTIN), 1024, kt * 64, nt * 64, 0, smem);
  } else if (it < 2304) {
    int j = it - 1920, br = j / 128, rr = j % 128, kt = rr / 16, nt = rr % 16;
    conv_tile(p.w_lift + ((long)l * 3 + br) * 512 * 1024, 1024, (u16*)(p.ws + OFF_WTLIFT) + (long)br * 1024 * 512, 512,
              kt * 64, nt * 64, 0, smem);
  } else if (it < 2560) {
    int j = it - 2304, kt = j / 16, nt = j % 16;
    conv_tile(p.w_out + (long)l * 1024 * 1024, 1024, (u16*)(p.ws + OFF_WTOUT), 1024, kt * 64, nt * 64, 0, smem);
  } else if (it < 3968) {
    int j = it - 2560, kt = j / 88, nt = j % 88;
    conv_tile(p.w_ffn_in + (long)l * 1024 * 5632, 5632, (u16*)(p.ws + OFF_WTFFI), 1024, kt * 64, nt * 64, 1, smem);
  } else {
    int j = it - 3968, kt = j / 16, nt = j % 16;
    conv_tile(p.w_ffn_out + (long)l * 2816 * 1024, 1024, (u16*)(p.ws + OFF_WTFFO), 2816, kt * 64, nt * 64, 0, smem);
  }
}

__device__ __forceinline__ void filter_item(const Params& p, int l, int ci, int sub, char* smem) {
  const int tid = otid();
  float* feats = (float*)smem;
  float* h1 = feats + 32 * 33;
  float* h2T = h1 + 2048;
  float* sw1 = h2T + 2048;
  float* sw2 = sw1 + 33 * 64;
  const int L = ci < 128 ? 4096 : 256;
  const int t0 = (ci < 128 ? ci : ci - 128) * 32;
  const float* w1 = p.fw1 + l * 33 * 64;
  const float* b1 = p.fb1 + l * 64;
  const float* w2 = p.fw2 + l * 64 * 64;
  const float* b2 = p.fb2 + l * 64;
  const float* w3 = p.fw3 + (long)l * 64 * 2048;
  const float* fr = p.ffreq + l * 64;
  __syncthreads();
  for (int e = tid; e < 33 * 64; e += 256) sw1[e] = w1[e];
  for (int e = tid; e < 64 * 64; e += 256) sw2[e] = w2[e];
  for (int e = tid; e < 32 * 33; e += 256) {
    int tt = e / 33, f = e % 33;
    float pos = (float)(t0 + tt);
    float val;
    if (f == 0) {
      val = pos / (float)L;
    } else {
      int bi = (f - 1) & 15;
      float band = 1e-4f + (15.f - 1e-4f) * (float)bi / 15.f;
      float ang = (6.283185307179586f / (float)L) * pos * band;
      val = f <= 16 ? cosf(ang) : -sinf(ang);
    }
    feats[e] = val;
  }
  __syncthreads();
  for (int e = tid; e < 2048; e += 256) {
    int tt = e >> 6, j = e & 63;
    float s = b1[j];
#pragma unroll 11
    for (int f = 0; f < 33; ++f) s += feats[tt * 33 + f] * sw1[f * 64 + j];
    h1[e] = sinf(fr[j] * s);
  }
  __syncthreads();
  for (int e = tid; e < 2048; e += 256) {
    int tt = e >> 6, j = e & 63;
    float s = b2[j];
#pragma unroll 16
    for (int k = 0; k < 64; ++k) s += h1[tt * 64 + k] * sw2[k * 64 + j];
    h2T[j * 32 + tt] = sinf(fr[j] * s);
  }
  __syncthreads();
  const float d0 = -3.0701134573253945f;
  const float d1 = -15.350567286626973f;
  {
    const int n = sub * 256 + tid;
    const int o = n >> 10, dir = (n >> 9) & 1, c = n & 511;
    const float adelta = fabsf(d0 + (d1 - d0) * (float)c / 511.f);
    u16* G = (u16*)(p.ws + (L == 4096 ? OFF_FILT1 : OFF_FILT0)) + (long)(o * 512 + c) * (2 * L);
    float asum = 0.f;
    float acc[2][16];
#pragma unroll
    for (int tg = 0; tg < 2; ++tg)
#pragma unroll
      for (int i = 0; i < 16; ++i) acc[tg][i] = 0.f;
#pragma unroll 1
    for (int kg = 0; kg < 4; ++kg) {
      float wv[16];
#pragma unroll
      for (int i = 0; i < 16; ++i) wv[i] = w3[(kg * 16 + i) * 2048 + n];
#pragma unroll
      for (int i = 0; i < 16; ++i) {
        const int k = kg * 16 + i;
#pragma unroll
        for (int tg = 0; tg < 2; ++tg)
#pragma unroll
          for (int q = 0; q < 4; ++q) {
            float4 hv = *(const float4*)(h2T + k * 32 + tg * 16 + q * 4);
            acc[tg][4 * q + 0] += hv.x * wv[i];
            acc[tg][4 * q + 1] += hv.y * wv[i];
            acc[tg][4 * q + 2] += hv.z * wv[i];
            acc[tg][4 * q + 3] += hv.w * wv[i];
          }
      }
    }
#pragma unroll
    for (int tg = 0; tg < 2; ++tg) {
#pragma unroll
      for (int tt = 0; tt < 16; ++tt) {
        int t = t0 + tg * 16 + tt;
        float val = acc[tg][tt] * expf(-((float)t / (float)L) * adelta);
        if (dir == 0 || t > 0) {
          asum += fabsf(val);
          G[dir ? L + t : L - t] = f2bf(val);
        }
      }
    }
    ((float*)(p.ws + OFF_FPART))[(long)ci * 2048 + n] = asum;
  }
}


using f32x4v = __attribute__((ext_vector_type(4))) float;
constexpr int F_BK = 64, F_HALF = 128, F_HT = F_HALF * F_BK;
__device__ __forceinline__ int f_lds_byte(int r, int c) {
  int st = (r >> 4) * 2 + (c >> 5), rr = r & 15, cc = c & 31, ob = rr * 64 + cc * 2;
  return st * 1024 + (ob ^ (((ob >> 9) & 1) << 5));
}
__device__ __forceinline__ void f_stage_rc(int b, int& R, int& C) {
  int st = b / 1024, sb = b % 1024, swz = sb ^ (((sb >> 9) & 1) << 5);
  R = (st >> 1) * 16 + swz / 64;
  C = (st & 1) * 32 + (swz % 64) / 2;
}
#define F_SA(b, h) (shm + ((b) * 2 + (h)) * F_HT)
#define F_SB(b, h) (shm + (4 + (b) * 2 + (h)) * F_HT)
#define F_STAGE(P, BASE, PITCH, br, kt)                                                              \
  do {                                                                                              \
    long _g = (long)(br) * (PITCH) + (long)(kt) * F_BK;                                             \
    for (int _i = 0; _i < 2; ++_i) {                                                                \
      int _b = tid * 16 + _i * 8192;                                                                \
      int _r, _c;                                                                                   \
      f_stage_rc(_b, _r, _c);                                                                       \
      __builtin_amdgcn_global_load_lds((const unsigned*)((BASE) + _g + (long)_r * (PITCH) + _c),    \
                                       (LAS unsigned*)((LAS char*)(P) + _b), 16, 0, 0);            \
    }                                                                                               \
  } while (0)
#define F_LDA(dst, b, h)                                                                            \
  for (int m = 0; m < 4; ++m)                                                                       \
    for (int k = 0; k < 2; ++k)                                                                     \
      dst[m][k] = *reinterpret_cast<const LAS bf16x8*>((const LAS char*)F_SA(b, h) + f_lds_byte(wr * 64 + m * 16 + fr, k * 32 + fq * 8))
#define F_LDB(dst, b, h)                                                                            \
  for (int n = 0; n < 2; ++n)                                                                       \
    for (int k = 0; k < 2; ++k)                                                                     \
      dst[n][k] = *reinterpret_cast<const LAS bf16x8*>((const LAS char*)F_SB(b, h) + f_lds_byte(wc * 32 + n * 16 + fr, k * 32 + fq * 8))
#define F_MMA(ai, bj, At, Bt_)                                                                      \
  do {                                                                                              \
    __builtin_amdgcn_s_setprio(1);                                                                  \
    for (int m = 0; m < 4; ++m)                                                                     \
      for (int n = 0; n < 2; ++n)                                                                   \
        for (int k = 0; k < 2; ++k)                                                                 \
          acc[ai][bj][m][n] = __builtin_amdgcn_mfma_f32_16x16x32_bf16(At[m][k], Bt_[n][k], acc[ai][bj][m][n], 0, 0, 0); \
    __builtin_amdgcn_s_setprio(0);                                                                  \
  } while (0)
#define F_WAIT_V(n) asm volatile("s_waitcnt vmcnt(" #n ")" ::: "memory")
#define F_WAIT_L(n) asm volatile("s_waitcnt lgkmcnt(" #n ")" ::: "memory")
#define F_BAR __builtin_amdgcn_s_barrier()
#define F_SCHED __builtin_amdgcn_sched_barrier(0)

__device__ __forceinline__ void gemm256(f32x4v (&acc)[2][2][4][2], const u16* __restrict__ A, long lda,
                                        const u16* __restrict__ Bt, long ldb, int K, LAS u16* shm) {
  const int tid = otid512();
  const int wid = tid >> 6, lane = tid & 63, wr = wid >> 2, wc = wid & 3, fr = lane & 15, fq = lane >> 4;
#pragma unroll
  for (int a = 0; a < 2; ++a)
#pragma unroll
    for (int b = 0; b < 2; ++b)
#pragma unroll
      for (int m = 0; m < 4; ++m)
#pragma unroll
        for (int n = 0; n < 2; ++n) acc[a][b][m][n] = f32x4v{0.f, 0.f, 0.f, 0.f};
  bf16x8 At[4][2], B0[2][2], B1[2][2];
  const int nt = K / F_BK;
  asm volatile("s_waitcnt vmcnt(0) lgkmcnt(0)" ::: "memory");
  __syncthreads();
  F_STAGE(F_SB(0, 0), Bt, ldb, 0, 0); F_STAGE(F_SA(0, 0), A, lda, 0, 0);
  F_STAGE(F_SB(0, 1), Bt, ldb, F_HALF, 0); F_STAGE(F_SA(0, 1), A, lda, F_HALF, 0);
  if (wr == 1) F_BAR;
  F_WAIT_V(4); F_BAR;
  F_STAGE(F_SB(1, 0), Bt, ldb, 0, 1); F_STAGE(F_SA(1, 0), A, lda, 0, 1); F_STAGE(F_SB(1, 1), Bt, ldb, F_HALF, 1);
  F_WAIT_V(6); F_BAR;
#pragma unroll 1
  for (int t = 0; t < nt - 2; t += 2) {
    F_LDB(B0, 0, 0); F_SCHED; F_LDA(At, 0, 0); F_STAGE(F_SA(1, 1), A, lda, F_HALF, t + 1);
    F_WAIT_L(8); F_BAR; F_WAIT_L(0); F_MMA(0, 0, At, B0); F_BAR; F_SCHED;
    F_LDB(B1, 0, 1); F_STAGE(F_SB(0, 0), Bt, ldb, 0, t + 2);
    F_BAR; F_WAIT_L(0); F_MMA(0, 1, At, B1); F_BAR;
    F_LDA(At, 0, 1); F_STAGE(F_SA(0, 0), A, lda, 0, t + 2);
    F_BAR; F_WAIT_L(0); F_MMA(1, 0, At, B0); F_BAR; F_SCHED;
    F_STAGE(F_SB(0, 1), Bt, ldb, F_HALF, t + 2);
    F_WAIT_V(6); F_BAR; F_MMA(1, 1, At, B1); F_BAR;
    F_LDB(B0, 1, 0); F_SCHED; F_LDA(At, 1, 0); F_STAGE(F_SA(0, 1), A, lda, F_HALF, t + 2);
    F_WAIT_L(8); F_BAR; F_WAIT_L(0); F_MMA(0, 0, At, B0); F_BAR; F_SCHED;
    F_LDB(B1, 1, 1); F_STAGE(F_SB(1, 0), Bt, ldb, 0, t + 3);
    F_BAR; F_WAIT_L(0); F_MMA(0, 1, At, B1); F_BAR;
    F_LDA(At, 1, 1); F_STAGE(F_SA(1, 0), A, lda, 0, t + 3);
    F_BAR; F_WAIT_L(0); F_MMA(1, 0, At, B0); F_BAR; F_SCHED;
    F_STAGE(F_SB(1, 1), Bt, ldb, F_HALF, t + 3);
    F_WAIT_V(6); F_BAR; F_MMA(1, 1, At, B1); F_BAR;
  }
  {
    F_LDB(B0, 0, 0); F_LDA(At, 0, 0); F_STAGE(F_SA(1, 1), A, lda, F_HALF, nt - 1);
    F_BAR; F_WAIT_L(0); F_MMA(0, 0, At, B0); F_BAR;
    F_LDB(B1, 0, 1); F_BAR; F_WAIT_L(0); F_MMA(0, 1, At, B1); F_BAR;
    F_LDA(At, 0, 1); F_WAIT_V(4); F_BAR; F_WAIT_L(0); F_MMA(1, 0, At, B0); F_MMA(1, 1, At, B1); F_BAR;
  }
  {
    F_LDB(B0, 1, 0); F_LDA(At, 1, 0); F_WAIT_V(2); F_BAR; F_WAIT_L(0); F_MMA(0, 0, At, B0); F_BAR;
    F_LDB(B1, 1, 1); F_WAIT_V(0); F_BAR; F_WAIT_L(0); F_MMA(0, 1, At, B1); F_BAR;
    F_LDA(At, 1, 1); F_BAR; F_WAIT_L(0); F_MMA(1, 0, At, B0); F_MMA(1, 1, At, B1); F_BAR;
  }
  if (wr == 0) F_BAR;
}

__device__ __forceinline__ void stage_store512(const u16* sC, int lds_ld, int cpr_log2, int nchunks, u16* dst, long ld) {
  const int tid = otid512();
  __syncthreads();
  for (int ch = tid; ch < nchunks; ch += 512) {
    int row = ch >> cpr_log2, c8 = (ch & ((1 << cpr_log2) - 1)) * 8;
    *(u32x4*)(dst + (long)row * ld + c8) = *(const u32x4*)(sC + row * lds_ld + c8);
  }
}


#define F_FOREACH(BODY)                                                                             \
  _Pragma("unroll") for (int ai = 0; ai < 2; ++ai)                                                  \
  _Pragma("unroll") for (int bj = 0; bj < 2; ++bj)                                                  \
  _Pragma("unroll") for (int m = 0; m < 4; ++m)                                                     \
  _Pragma("unroll") for (int n = 0; n < 2; ++n)                                                     \
  _Pragma("unroll") for (int j = 0; j < 4; ++j) {                                                   \
    const int R = ai * 128 + wr * 64 + m * 16 + fq * 4 + j;                                         \
    const int C = bj * 128 + wc * 32 + n * 16 + fr;                                                 \
    BODY                                                                                            \
  }

__device__ __forceinline__ void gemm_in_fast(const Params& p, int l, int tile, LAS char* smem) {
  LAS u16* shm = (LAS u16*)smem;
  u16* sm = (u16*)smem;
  const int mt = tile / 30, nt = tile % 30, m0 = mt * 256, n0 = nt * 256;
  f32x4v acc[2][2][4][2];
  const u16* X = (const u16*)(p.ws + OFF_HBUF) + (long)m0 * 1024;
  const u16* W = (const u16*)(p.ws + OFF_WTIN) + (long)n0 * 1024;
  if (nt < 6) {
    gemm256(acc, W, 1024, X, 1024, 1024, shm);
    const int tid = otid512(), wid = tid >> 6, lane = tid & 63, wr = wid >> 2, wc = wid & 3, fr = lane & 15, fq = lane >> 4;
    F_FOREACH(sm[R * 264 + C] = f2bf(acc[ai][bj][m][n][j]);)
    stage_store512(sm, 264, 5, 8192, (u16*)(p.ws + OFF_UHYT) + (long)n0 * T_TOK + m0, T_TOK);
  } else {
    gemm256(acc, X, 1024, W, 1024, 1024, shm);
    const int tid = otid512(), wid = tid >> 6, lane = tid & 63, wr = wid >> 2, wc = wid & 3, fr = lane & 15, fq = lane >> 4;
    const int region = (n0 - 1536) >> 9;
    const bool prompt = m0 < NPR;
    const bool rope = (!prompt) && (region == 3 || region == 4);
    float* outp = nullptr;
    if (prompt) {
      if (region == 1) outp = p.out + OUT_NAK;
      else if (region == 2) outp = p.out + OUT_NAK + OUT_SZ;
      else if (region == 4) outp = p.out + OUT_NAK + 2 * OUT_SZ;
      else if (region == 5) outp = p.out + OUT_NAK + 3 * OUT_SZ;
    }
    const float* rc = (const float*)(p.ws + OFF_ROPE);
    F_FOREACH(
      const int mm = m0 + R; const int nn = n0 + C;
      float v = acc[ai][bj][m][n][j];
      if (rope) {
        float pr = shx(v, lane, 1);
        int d = nn & 31; int pi = d >> 1;
        int tq = (mm - NPR) & 4095;
        int pos = pi < 8 ? (tq >> 6) : (tq & 63);
        float cs = rc[pos * 8 + (pi & 7)]; float sn = rc[512 + pos * 8 + (pi & 7)];
        v = (nn & 1) ? (pr * sn + v * cs) : (v * cs - pr * sn);
      }
      sm[R * 264 + C] = f2bf(v);
      if (outp) outp[((long)((mm >> 8) * 4 + l) * 256 + (mm & 255)) * 512 + ((nn - 1536) & 511)] = v;
    )
    stage_store512(sm, 264, 5, 8192, (u16*)(p.ws + OFF_URM) + (long)m0 * 6144 + (n0 - 1536), 6144);
  }
}

__device__ __forceinline__ void ffn_in_fast(const Params& p, int l, int tile, LAS char* smem) {
  LAS u16* shm = (LAS u16*)smem;
  u16* sm = (u16*)smem;
  const int mt = tile / 22, nt = tile % 22, m0 = mt * 256, n0 = nt * 256;
  f32x4v acc[2][2][4][2];
  gemm256(acc, (const u16*)(p.ws + OFF_HBUF) + (long)m0 * 1024, 1024,
          (const u16*)(p.ws + OFF_WTFFI) + (long)n0 * 1024, 1024, 1024, shm);
  const int tid = otid512(), wid = tid >> 6, lane = tid & 63, wr = wid >> 2, wc = wid & 3, fr = lane & 15, fq = lane >> 4;
#pragma unroll
  for (int ai = 0; ai < 2; ++ai)
#pragma unroll
    for (int bj = 0; bj < 2; ++bj)
#pragma unroll
      for (int m = 0; m < 4; ++m)
#pragma unroll
        for (int j = 0; j < 4; ++j) {
          const int R = ai * 128 + wr * 64 + m * 16 + fq * 4 + j;
          const int C = bj * 64 + wc * 16 + fr;
          const float gv = acc[ai][bj][m][0][j], uv = acc[ai][bj][m][1][j];
          sm[R * 136 + C] = f2bf(gv * __builtin_amdgcn_rcpf(1.f + __expf(-gv)) * uv);
        }
  stage_store512(sm, 136, 4, 4096, (u16*)(p.ws + OFF_URM) + (long)m0 * 2816 + nt * 128, 2816);
}

__device__ __forceinline__ void resid_fast(const Params& p, int l, int which, int tile, LAS char* smem) {
  LAS u16* shm = (LAS u16*)smem;
  const int mt = tile >> 2, nt = tile & 3, m0 = mt * 256, n0 = nt * 256;
  f32x4v acc[2][2][4][2];
  if (which == 0) {
    gemm256(acc, (const u16*)(p.ws + OFF_HBUF) + (long)m0 * 1024, 1024,
            (const u16*)(p.ws + OFF_WTOUT) + (long)n0 * 1024, 1024, 1024, shm);
  } else {
    gemm256(acc, (const u16*)(p.ws + OFF_URM) + (long)m0 * 2816, 2816,
            (const u16*)(p.ws + OFF_WTFFO) + (long)n0 * 2816, 2816, 2816, shm);
  }
  const int tid = otid512(), wid = tid >> 6, lane = tid & 63, wr = wid >> 2, wc = wid & 3, fr = lane & 15, fq = lane >> 4;
  const float* gate = mod_row(p, l, m0) + (which == 0 ? 2048 : 5120) + n0;
  const float* xbase = ((which == 0 && l == 0) ? (m0 < NPR ? p.x_prompt + (long)m0 * 1024 : p.x_sample + (long)(m0 - NPR) * 1024)
                                               : p.out + (long)m0 * 1024) + n0;
  float* obase = p.out + (long)m0 * 1024 + n0;
  F_FOREACH(
    obase[R * 1024 + C] = xbase[R * 1024 + C] + gate[C] * acc[ai][bj][m][n][j];
  )
}

__device__ __forceinline__ void tile_swz(int it, int ncg, int& mt, int& nt) {
  const int x = it & 7, q = it >> 3;
  const int g = q >> 5, e = q & 31;
  const int sid = x * (3 * ncg) + g;
  const int smt = sid / ncg, snt = sid - smt * ncg;
  mt = smt * 8 + (e >> 2);
  nt = snt * 4 + (e & 3);
}

__device__ __forceinline__ void gemm_in_item(const Params& p, int l, int tile, char* smem) {
  u16* sm = (u16*)smem;
  const int tid = otid(), lane = tid & 63, w = tid >> 6, wm = w & 1, wn = w >> 1, r = lane & 31, h = lane >> 5;
  int mt, nt;
  tile_swz(tile, 15, mt, nt);
  const int m0 = mt * 128, n0 = nt * 128;
  f32x16 acc[2][2];
  zero_acc(acc);
  const u16* A = (const u16*)(p.ws + OFF_HBUF) + (long)m0 * 1024;
  const u16* B = (const u16*)(p.ws + OFF_WTIN) + (long)n0 * 1024;
  if (nt < 12) {
    gemm_tile<true, 2>(acc, A, 1024, B, 1024, 1024, sm);
#pragma unroll
    for (int i = 0; i < 2; ++i)
#pragma unroll
      for (int j = 0; j < 2; ++j)
#pragma unroll
        for (int g = 0; g < 16; ++g) {
          int R = wn * 64 + j * 32 + rowmap(g, h);
          int C = wm * 64 + i * 32 + r;
          sm[R * 136 + C] = f2bf(acc[i][j][g]);
        }
    stage_store(sm, 136, 4, 2048, (u16*)(p.ws + OFF_UHYT) + (long)n0 * T_TOK + m0, T_TOK);
  } else {
    gemm_tile<false, 2>(acc, A, 1024, B, 1024, 1024, sm);
    const int region = (n0 - 1536) >> 9;
    const bool prompt = m0 < NPR;
    const bool rope = (!prompt) && (region == 3 || region == 4);
    float* outp = nullptr;
    if (prompt) {
      if (region == 1) outp = p.out + OUT_NAK;
      else if (region == 2) outp = p.out + OUT_NAK + OUT_SZ;
      else if (region == 4) outp = p.out + OUT_NAK + 2 * OUT_SZ;
      else if (region == 5) outp = p.out + OUT_NAK + 3 * OUT_SZ;
    }
    const float* rc = (const float*)(p.ws + OFF_ROPE);
#pragma unroll
    for (int i = 0; i < 2; ++i)
#pragma unroll
      for (int j = 0; j < 2; ++j)
#pragma unroll
        for (int g = 0; g < 16; ++g) {
          int R = wm * 64 + i * 32 + rowmap(g, h);
          int C = wn * 64 + j * 32 + r;
          int m = m0 + R, n = n0 + C;
          float v = acc[i][j][g];
          if (rope) {
            float pr = shx(v, lane, 1);
            int d = n & 31, pi = d >> 1;
            int tq = (m - NPR) & 4095;
            int pos = pi < 8 ? (tq >> 6) : (tq & 63);
            float cs = rc[pos * 8 + (pi & 7)], sn = rc[512 + pos * 8 + (pi & 7)];
            v = (n & 1) ? (pr * sn + v * cs) : (v * cs - pr * sn);
          }
          sm[R * 136 + C] = f2bf(v);
          if (outp) outp[((long)((m >> 8) * 4 + l) * 256 + (m & 255)) * 512 + ((n - 1536) & 511)] = v;
        }
    stage_store(sm, 136, 4, 2048, (u16*)(p.ws + OFF_URM) + (long)m0 * 6144 + (n0 - 1536), 6144);
  }
}

__device__ __forceinline__ void lift_item(const Params& p, int l, int tile, char* smem) {
  constexpr int NJ = 1;
  constexpr bool SWAP = false;
  u16* sm = (u16*)smem;
  const int tid = otid(), lane = tid & 63, w = tid >> 6, wm = w & 1, wn = w >> 1, r = lane & 31, h = lane >> 5;
  int mt, nt;
  tile_swz(tile, 4, mt, nt);
  const int m0 = mt * 128, n0 = nt * 64;
  const u16* urm = (const u16*)(p.ws + OFF_URM);
  const int lrow = tid >> 3, lkc = (tid & 7) * 8;
  const u16* a0p = (const u16*)(p.ws + OFF_YHY) + (long)(m0 + lrow) * 512 + lkc;
  const u16* a1p = urm + (long)(m0 + lrow) * 6144 + lkc;
  const u16* b0p = (const u16*)(p.ws + OFF_WTLIFT) + (long)(n0 + lrow) * 512 + lkc;
  f32x16 tot[2], acc[2][1];
  tot[0] = zero16();
  tot[1] = zero16();
  acc[0][0] = zero16();
  acc[1][0] = zero16();
  u32x4 ra0[4], rb0[2], ra1[4], rb1[2], ra2[4], rb2[2], ra3[4], rb3[2];
#define LIFT_LOAD(RA, RB, KI)                                                                       \
  {                                                                                                 \
    const int ki_ = ((KI) < 24) ? (KI) : 23;     \
    const int seg_ = ki_ >> 3, kk_ = (ki_ & 7) * 64;                                                \
    const u16* ap = (seg_ == 0) ? (a0p + kk_) : (a1p + (seg_ == 1 ? 0 : 1536) + kk_);               \
    const long lda = (seg_ == 0) ? 512 : 6144;                                                      \
    const u16* bp = b0p + (long)seg_ * 1024 * 512 + kk_;                                            \
    const long ldb = 512;                                                                           \
    GEMM_LOAD(RA, RB, 0)                                                                            \
  }
#define LIFT_STEP(K, RA, RB)                                                                        \
  {                                                                                                 \
    const int k = (K);                                                                              \
    const int cur = k & 1;                                                                          \
    if ((k & 7) == 0) {                                                                             \
      const int br = k >> 3;                                                                        \
      _Pragma("unroll") for (int i = 0; i < 2; ++i)                                                 \
        _Pragma("unroll") for (int g = 0; g < 16; ++g) {                                            \
          int m = m0 + wm * 64 + i * 32 + rowmap(g, h);                                             \
          int n = n0 + wn * 32 + r;                                                                 \
          gq[i][g] = urm[(long)m * 6144 + 3072 + br * 1024 + n];                                    \
        }                                                                                           \
    }                                                                                               \
    GEMM_COMPUTE_HALF(cur, 0)                                                                       \
    __builtin_amdgcn_sched_barrier(0);                                                              \
    if (k + 1 < 24) GEMM_STORE(RA, RB, cur ^ 1)                                                     \
    LIFT_LOAD(RA, RB, k + 5)                                                                        \
    __builtin_amdgcn_sched_barrier(0);                                                              \
    GEMM_COMPUTE_HALF(cur, 2)                                                                       \
    __syncthreads();                                                                                \
    if ((k & 7) == 7) {                                                                             \
      _Pragma("unroll") for (int i = 0; i < 2; ++i)                                                 \
        _Pragma("unroll") for (int g = 0; g < 16; ++g) {                                            \
          float gt = bf2f(gq[i][g]);                                                                \
          tot[i][g] += acc[i][0][g] * __builtin_amdgcn_rcpf(1.f + __expf(-gt));                                          \
          acc[i][0][g] = 0.f;                                                                       \
        }                                                                                           \
    }                                                                                               \
  }
  LIFT_LOAD(ra0, rb0, 0)
  LIFT_LOAD(ra1, rb1, 1)
  LIFT_LOAD(ra2, rb2, 2)
  LIFT_LOAD(ra3, rb3, 3)
  __syncthreads();
  GEMM_STORE(ra0, rb0, 0)
  LIFT_LOAD(ra0, rb0, 4)
  __syncthreads();
  u16 gq[2][16];
#pragma unroll 1
  for (int kk = 0; kk < 24; kk += 4) {
    LIFT_STEP(kk + 0, ra1, rb1)
    LIFT_STEP(kk + 1, ra2, rb2)
    LIFT_STEP(kk + 2, ra3, rb3)
    LIFT_STEP(kk + 3, ra0, rb0)
  }
#undef LIFT_STEP
#undef LIFT_LOAD
#pragma unroll
  for (int i = 0; i < 2; ++i)
#pragma unroll
    for (int g = 0; g < 16; ++g) {
      int R = wm * 64 + i * 32 + rowmap(g, h);
      int C = wn * 32 + r;
      sm[R * 72 + C] = f2bf(tot[i][g]);
    }
  stage_store(sm, 72, 3, 1024, (u16*)(p.ws + OFF_HBUF) + (long)m0 * 1024 + n0, 1024);
}


__device__ __forceinline__ void lift_pair_item(const Params& p, int l, int pair, char* smem) {
  const int tid = otid512(), half = tid >> 8, ht = tid & 255;
  const int lane = ht & 63, w = ht >> 6, wm = w & 1, wn = w >> 1, r = lane & 31, h = lane >> 5;
  u16* sAall = (u16*)smem;
  u16* sBme = (u16*)smem + 2 * 128 * 72 + half * (2 * 64 * 72);
  u16* sOut = (u16*)smem + 2 * 128 * 72 + 2 * (2 * 64 * 72) + half * (128 * 72);
  int mt, ntp;
  tile_swz(pair, 2, mt, ntp);
  const int m0 = mt * 128, n0 = (2 * ntp + half) * 64;
  const u16* urm = (const u16*)(p.ws + OFF_URM);
  const int arow = tid >> 3, akc = (tid & 7) * 8;
  const int brow = ht >> 3, bkc = (ht & 7) * 8;
  const u16* a0p = (const u16*)(p.ws + OFF_YHY) + (long)(m0 + arow) * 512 + akc;
  const u16* a1p = urm + (long)(m0 + arow) * 6144 + akc;
  const u16* b0p = (const u16*)(p.ws + OFF_WTLIFT) + (long)(n0 + brow) * 512 + bkc;
  f32x16 tot[2], acc[2];
  tot[0] = zero16(); tot[1] = zero16(); acc[0] = zero16(); acc[1] = zero16();
  u32x4 ra0[2], rb0[2], ra1[2], rb1[2], ra2[2], rb2[2], ra3[2], rb3[2];
#define LS_LOAD(RA, RB, KI)                                                                         \
  {                                                                                                 \
    const int ki_ = ((KI) < 24) ? (KI) : 23;                                                        \
    const int seg_ = ki_ >> 3, kk_ = (ki_ & 7) * 64;                                                \
    const u16* ap_ = (seg_ == 0) ? (a0p + kk_) : (a1p + (seg_ == 1 ? 0 : 1536) + kk_);             \
    const long lda_ = (seg_ == 0) ? 512 : 6144;                                                     \
    const u16* bp_ = b0p + (long)seg_ * 1024 * 512 + kk_;                                           \
    RA[0] = *(const u32x4*)(ap_);                                                                   \
    RA[1] = *(const u32x4*)(ap_ + 64 * lda_);                                                       \
    RB[0] = *(const u32x4*)(bp_);                                                                   \
    RB[1] = *(const u32x4*)(bp_ + 32 * 512);                                                        \
  }
#define LS_STORE(RA, RB, STG)                                                                       \
  {                                                                                                 \
    u16* dA_ = sAall + (STG) * (128 * 72);                                                          \
    u16* dB_ = sBme + (STG) * (64 * 72);                                                            \
    *(u32x4*)(dA_ + arow * 72 + akc) = RA[0];                                                       \
    *(u32x4*)(dA_ + (arow + 64) * 72 + akc) = RA[1];                                                \
    *(u32x4*)(dB_ + brow * 72 + bkc) = RB[0];                                                       \
    *(u32x4*)(dB_ + (brow + 32) * 72 + bkc) = RB[1];                                                \
  }
#define LS_COMPUTE(STG, KS0)                                                                        \
  {                                                                                                 \
    const u16* sA_ = sAall + (STG) * (128 * 72);                                                    \
    const u16* sB_ = sBme + (STG) * (64 * 72);                                                      \
    __builtin_amdgcn_s_setprio(1);                                                                  \
    _Pragma("unroll") for (int ks = (KS0); ks < (KS0) + 2; ++ks) {                                  \
      bf16x8 af0 = *(const bf16x8*)(sA_ + (wm * 64 + r) * 72 + ks * 16 + h * 8);                    \
      bf16x8 af1 = *(const bf16x8*)(sA_ + (wm * 64 + 32 + r) * 72 + ks * 16 + h * 8);               \
      bf16x8 bf0 = *(const bf16x8*)(sB_ + (wn * 32 + r) * 72 + ks * 16 + h * 8);                    \
      acc[0] = mfma32(af0, bf0, acc[0]);                                                            \
      acc[1] = mfma32(af1, bf0, acc[1]);                                                            \
    }                                                                                               \
    __builtin_amdgcn_s_setprio(0);                                                                  \
  }
#define LS_STEP(K, RA, RB)                                                                          \
  {                                                                                                 \
    const int k = (K);                                                                              \
    const int cur = k & 1;                                                                          \
    if ((k & 7) == 0) {                                                                             \
      const int br = k >> 3;                                                                        \
      _Pragma("unroll") for (int i = 0; i < 2; ++i)                                                 \
        _Pragma("unroll") for (int g = 0; g < 16; ++g) {                                            \
          int m = m0 + wm * 64 + i * 32 + rowmap(g, h);                                             \
          int n = n0 + wn * 32 + r;                                                                 \
          gq[i][g] = urm[(long)m * 6144 + 3072 + br * 1024 + n];                                    \
        }                                                                                           \
    }                                                                                               \
    LS_COMPUTE(cur, 0)                                                                              \
    __builtin_amdgcn_sched_barrier(0);                                                              \
    if (k + 1 < 24) LS_STORE(RA, RB, cur ^ 1)                                                       \
    LS_LOAD(RA, RB, k + 5)                                                                          \
    __builtin_amdgcn_sched_barrier(0);                                                              \
    LS_COMPUTE(cur, 2)                                                                              \
    __syncthreads();                                                                                \
    if ((k & 7) == 7) {                                                                             \
      _Pragma("unroll") for (int i = 0; i < 2; ++i)                                                 \
        _Pragma("unroll") for (int g = 0; g < 16; ++g) {                                            \
          float gt = bf2f(gq[i][g]);                                                                \
          tot[i][g] += acc[i][g] * __builtin_amdgcn_rcpf(1.f + __expf(-gt));                                             \
          acc[i][g] = 0.f;                                                                          \
        }                                                                                           \
    }                                                                                               \
  }
  LS_LOAD(ra0, rb0, 0)
  LS_LOAD(ra1, rb1, 1)
  LS_LOAD(ra2, rb2, 2)
  LS_LOAD(ra3, rb3, 3)
  __syncthreads();
  LS_STORE(ra0, rb0, 0)
  LS_LOAD(ra0, rb0, 4)
  __syncthreads();
  u16 gq[2][16];
#pragma unroll 1
  for (int kk = 0; kk < 24; kk += 4) {
    LS_STEP(kk + 0, ra1, rb1)
    LS_STEP(kk + 1, ra2, rb2)
    LS_STEP(kk + 2, ra3, rb3)
    LS_STEP(kk + 3, ra0, rb0)
  }
#undef LS_STEP
#undef LS_COMPUTE
#undef LS_STORE
#undef LS_LOAD
#pragma unroll
  for (int i = 0; i < 2; ++i)
#pragma unroll
    for (int g = 0; g < 16; ++g) {
      int R = wm * 64 + i * 32 + rowmap(g, h);
      int C = wn * 32 + r;
      sOut[R * 72 + C] = f2bf(tot[i][g]);
    }
  __syncthreads();
  for (int ch = ht; ch < 1024; ch += 256) {
    int row = ch >> 3, c8 = (ch & 7) * 8;
    *(u32x4*)((u16*)(p.ws + OFF_HBUF) + (long)(m0 + row) * 1024 + n0 + c8) = *(const u32x4*)(sOut + row * 72 + c8);
  }
}

__device__ __forceinline__ void resid_item(const Params& p, int l, int which, int tile, char* smem) {
  u16* sm = (u16*)smem;
  const int tid = otid(), lane = tid & 63, w = tid >> 6, wm = w & 1, wn = w >> 1, r = lane & 31, h = lane >> 5;
  int mt, nt;
  tile_swz(tile, 2, mt, nt);
  const int m0 = mt * 128, n0 = nt * 128;
  f32x16 acc[2][2];
  zero_acc(acc);
  if (which == 0) {
    gemm_tile<false, 2>(acc, (const u16*)(p.ws + OFF_HBUF) + (long)m0 * 1024, 1024,
                     (const u16*)(p.ws + OFF_WTOUT) + (long)n0 * 1024, 1024, 1024, sm);
  } else {
    gemm_tile<false, 2>(acc, (const u16*)(p.ws + OFF_URM) + (long)m0 * 2816, 2816,
                     (const u16*)(p.ws + OFF_WTFFO) + (long)n0 * 2816, 2816, 2816, sm);
  }
  const float* gate = mod_row(p, l, m0) + (which == 0 ? 2048 : 5120);
#pragma unroll
  for (int i = 0; i < 2; ++i)
#pragma unroll
    for (int j = 0; j < 2; ++j)
#pragma unroll
      for (int g = 0; g < 16; ++g) {
        int m = m0 + wm * 64 + i * 32 + rowmap(g, h);
        int n = n0 + wn * 64 + j * 32 + r;
        const float* xi = (which == 0) ? xin_row(p, l, m) : p.out + (long)m * 1024;
        p.out[(long)m * 1024 + n] = xi[n] + gate[n] * acc[i][j][g];
      }
}

__device__ __forceinline__ void ffn_in_item(const Params& p, int l, int tile, char* smem) {
  u16* sm = (u16*)smem;
  const int tid = otid(), lane = tid & 63, w = tid >> 6, wm = w & 1, wn = w >> 1, r = lane & 31, h = lane >> 5;
  int mt, nt;
  tile_swz(tile, 11, mt, nt);
  const int m0 = mt * 128, n0 = nt * 128;
  f32x16 acc[2][2];
  zero_acc(acc);
  gemm_tile<false, 2>(acc, (const u16*)(p.ws + OFF_HBUF) + (long)m0 * 1024, 1024,
                   (const u16*)(p.ws + OFF_WTFFI) + (long)n0 * 1024, 1024, 1024, sm);
#pragma unroll
  for (int i = 0; i < 2; ++i)
#pragma unroll
    for (int g = 0; g < 16; ++g) {
      int R = wm * 64 + i * 32 + rowmap(g, h);
      int C = wn * 32 + r;
      float gv = acc[i][0][g], uv = acc[i][1][g];
      sm[R * 72 + C] = f2bf(gv * __builtin_amdgcn_rcpf(1.f + __expf(-gv)) * uv);
    }
  stage_store(sm, 72, 3, 1024, (u16*)(p.ws + OFF_URM) + (long)m0 * 2816 + nt * 64, 2816);
}

template <int L, int NTOK, bool PADDED>
__device__ __forceinline__ void hy_stage(const u16* __restrict__ src, float w0, float w1, float w2, float bb, u16* dst,
                                         int tid) {
#pragma unroll
  for (int it = 0; it < NTOK / 8 / 256; ++it) {
    const int q = (tid + 256 * it) * 8;
    const int s = q & (L - 1);
    const u32x4 v = *(const u32x4*)(src + q);
    const u16 lft = (s > 0) ? src[q - 1] : (u16)0;
    const u16 rgt = (s + 8 < L) ? src[q + 8] : (u16)0;
    float x[10];
    x[0] = bf2f(lft);
#pragma unroll
    for (int e = 0; e < 4; ++e) {
      x[1 + 2 * e] = __uint_as_float(v[e] << 16);
      x[2 + 2 * e] = __uint_as_float(v[e] & 0xffff0000u);
    }
    x[9] = bf2f(rgt);
    u32x4 o;
#pragma unroll
    for (int e = 0; e < 4; ++e) {
      float y0 = x[2 * e] * w0 + x[2 * e + 1] * w1 + x[2 * e + 2] * w2 + bb;
      float y1 = x[2 * e + 1] * w0 + x[2 * e + 2] * w1 + x[2 * e + 3] * w2 + bb;
      o[e] = pk2(y0, y1);
    }
    *(u32x4*)(dst + (PADDED ? ((q >> 6) * 72 + (q & 63)) : q)) = o;
  }
}

template <int NB>
__device__ __forceinline__ void hyena_item(const Params& p, int l, int c, char* smem) {
  constexpr int L = NB * 64;
  constexpr int NBATCH = (NB == 64) ? 4 : 32;
  constexpr int NQ = (NB == 64) ? 4 : 2;
  constexpr int NTOK = NBATCH * L;
  constexpr int HS = 2 * L + 32;
  const int tid = otid(), lane = tid & 63, w = tid >> 6, r = lane & 31, h = lane >> 5;
  u16* sZ = (u16*)smem;
  u16* sH = sZ + (NBATCH * NB + 1) * 72;
  const int seq0 = (NB == 64) ? NPR : 0;
  const u16* uh = (const u16*)(p.ws + OFF_UHYT);
  const u16* G = (const u16*)(p.ws + (NB == 64 ? OFF_FILT1 : OFF_FILT0));
  const float* P = (const float*)(p.ws + OFF_FPART) + (NB == 64 ? 0 : 128 * 2048);
  float as0 = 0.f, as1 = 0.f;
  {
    float* red = (float*)smem;
    __syncthreads();
    float v0 = 0.f, v1 = 0.f;
    for (int e = tid; e < NB * 8; e += 256) {
      const int ch = e >> 2, od = e & 3;
      const float pv = P[ch * 2048 + od * 512 + c];
      if (od < 2) v0 += pv; else v1 += pv;
    }
#pragma unroll
    for (int o = 32; o >= 1; o >>= 1) {
      v0 += shx(v0, lane, o);
      v1 += shx(v1, lane, o);
    }
    if (lane == 0) {
      red[w * 2] = v0;
      red[w * 2 + 1] = v1;
    }
    __syncthreads();
    as0 = red[0] + red[2] + red[4] + red[6];
    as1 = red[1] + red[3] + red[5] + red[7];
  }
  const float bias0 = p.hy_bias[(l * 2 + 0) * 512 + c], bias1 = p.hy_bias[(l * 2 + 1) * 512 + c];
  const int ah = w & 1, cgp = w >> 1;
  int zb[NQ], ii[NQ];
#pragma unroll
  for (int q = 0; q < NQ; ++q) {
    int col = (cgp + 2 * q) * 32 + r;
    zb[q] = (col / NB) * NB;
    ii[q] = col % NB;
  }
  const int dmin = (NB == 64) ? 32 * cgp - 63 : -3;
  const int dmax = (NB == 64) ? 32 * cgp + 31 : 3;
  __syncthreads();
  if (tid < 36) ((unsigned*)(sZ + NBATCH * NB * 72))[tid] = 0u;
#pragma unroll 1
  for (int ord = 0; ord < 2; ++ord) {
    if (ord == 0) {
      const int chn = c;
      const u16* src = uh + (long)chn * T_TOK + seq0;
      const float w0 = p.hy_conv_w[(l * 3 + 0) * 1536 + chn], w1 = p.hy_conv_w[(l * 3 + 1) * 1536 + chn],
                  w2 = p.hy_conv_w[(l * 3 + 2) * 1536 + chn], bb = p.hy_conv_b[l * 1536 + chn];
      hy_stage<L, NTOK, true>(src, w0, w1, w2, bb, sZ, tid);
    }
    {
      const u16* Gc = G + (long)(ord * 512 + c) * (2 * L);
#pragma unroll
      for (int it = 0; it < (2 * L / 8 + 255) / 256; ++it) {
        const int vi = tid + 256 * it;
        if (vi < 2 * L / 8) {
          u32x4 A4 = *(const u32x4*)(Gc + 8 * vi);
          const unsigned nxt = (8 * vi + 8 < 2 * L) ? (unsigned)Gc[8 * vi + 8] : 0u;
          if (vi == 0) A4[0] &= 0xffff0000u;
          u32x4 B4;
          B4[0] = (A4[0] >> 16) | (A4[1] << 16);
          B4[1] = (A4[1] >> 16) | (A4[2] << 16);
          B4[2] = (A4[2] >> 16) | (A4[3] << 16);
          B4[3] = (A4[3] >> 16) | (nxt << 16);
          *(u32x4*)(sH + 8 * vi) = A4;
          *(u32x4*)(sH + HS + 8 * vi) = B4;
        }
      }
      if (tid < 8) {
        sH[2 * L + tid] = 0;
        sH[HS + 2 * L + tid] = 0;
      }
    }
    __syncthreads();
    f32x16 acc[NQ];
#pragma unroll
    for (int q = 0; q < NQ; ++q) acc[q] = zero16();
    const LAS char* zbase = (const LAS char*)sZ;
    int zoff0[NQ];
#pragma unroll
    for (int q = 0; q < NQ; ++q) zoff0[q] = ((zb[q] + ii[q]) * 72 + h * 8) * 2;
    const int zzero = (NBATCH * NB * 72 + h * 8) * 2;
    const LAS char* hbase = (const LAS char*)sH + ((r & 1) * HS) * 2;
#define HY_PTRS(D, HP, ZP)                                                                          \
    {                                                                                               \
      const int e0_ = L - (64 * (D) + 32 * ah + r - 8 * h);                                          \
      HP = (const LAS unsigned*)(hbase + (e0_ & ~1) * 2);                                            \
      _Pragma("unroll") for (int q = 0; q < NQ; ++q) {                                               \
        const bool ok_ = (unsigned)(ii[q] - (D)) < (unsigned)NB;                                     \
        ZP[q] = zbase + (ok_ ? (zoff0[q] - (D) * 144) : zzero);                                      \
      }                                                                                             \
    }
#define HY_LOAD(TF, ZF, HP, ZP, KB)                                                                 \
    {                                                                                               \
      u32x4 tu_;                                                                                    \
      tu_[0] = HP[(KB) * 8 + 0];                                                                    \
      tu_[1] = HP[(KB) * 8 + 1];                                                                    \
      tu_[2] = HP[(KB) * 8 + 2];                                                                    \
      tu_[3] = HP[(KB) * 8 + 3];                                                                    \
      TF = (bf16x8)tu_;                                                                             \
      _Pragma("unroll") for (int q = 0; q < NQ; ++q) ZF[q] = *(const LAS bf16x8*)(ZP[q] + (KB) * 32); \
    }
#define HY_MMA(TF, ZF)                                                                              \
    {                                                                                               \
      __builtin_amdgcn_s_setprio(1);                                                                \
      _Pragma("unroll") for (int q = 0; q < NQ; ++q) acc[q] = mfma32(TF, ZF[q], acc[q]);             \
      __builtin_amdgcn_s_setprio(0);                                                                \
    }
    const LAS unsigned* hp;
    const LAS char* zp[NQ];
    const LAS unsigned* hpn;
    const LAS char* zpn[NQ];
    bf16x8 tA, tB, zA[NQ], zB[NQ];
    HY_PTRS(dmin, hp, zp)
    HY_LOAD(tA, zA, hp, zp, 0)
#pragma unroll 1
    for (int d = dmin; d <= dmax; ++d) {
      const int dn = (d < dmax) ? d + 1 : d;
      HY_PTRS(dn, hpn, zpn)
      HY_LOAD(tB, zB, hp, zp, 1)
      HY_MMA(tA, zA)
      __builtin_amdgcn_sched_barrier(0);
      HY_LOAD(tA, zA, hp, zp, 2)
      HY_MMA(tB, zB)
      __builtin_amdgcn_sched_barrier(0);
      HY_LOAD(tB, zB, hp, zp, 3)
      HY_MMA(tA, zA)
      __builtin_amdgcn_sched_barrier(0);
      HY_LOAD(tA, zA, hpn, zpn, 0)
      HY_MMA(tB, zB)
      __builtin_amdgcn_sched_barrier(0);
      hp = hpn;
#pragma unroll
      for (int q = 0; q < NQ; ++q) zp[q] = zpn[q];
    }
#undef HY_MMA
#undef HY_LOAD
#undef HY_PTRS
    __syncthreads();
    {
      const int chn = (ord + 1) * 512 + c;
      const u16* src = uh + (long)chn * T_TOK + seq0;
      const float w0 = p.hy_conv_w[(l * 3 + 0) * 1536 + chn], w1 = p.hy_conv_w[(l * 3 + 1) * 1536 + chn],
                  w2 = p.hy_conv_w[(l * 3 + 2) * 1536 + chn], bb = p.hy_conv_b[l * 1536 + chn];
      hy_stage<L, NTOK, false>(src, w0, w1, w2, bb, sH, tid);
    }
    __syncthreads();
    const float scl = 1.f / (ord == 0 ? as0 : as1);
    const float bia = ord == 0 ? bias0 : bias1;
    u16* yh = (u16*)(p.ws + OFF_YHY);
#pragma unroll
    for (int q = 0; q < NQ; ++q) {
      int blk = zb[q] + ii[q];
      asm volatile("" : "+v"(blk));
#pragma unroll
      for (int g = 0; g < 16; ++g) {
        const int a = 32 * ah + rowmap(g, h);
        const int zidx = blk * 72 + a;
        const int flat = blk * 64 + a;
        float y = acc[q][g] * scl;
        float zv = bf2f(sZ[zidx]);
        float xg = bf2f(sH[flat]);
        float res = xg * (y + zv * bia);
        if (ord == 0) sZ[zidx] = f2bf(res);
        else yh[(long)(seq0 + flat) * 512 + c] = f2bf(res);
        if ((g & 3) == 3) __builtin_amdgcn_sched_barrier(0);
      }
    }
    __syncthreads();
  }
}

template <int MODE>
__device__ __forceinline__ void attn_item(const Params& p, int l, int item, char* smem) {
  constexpr bool DA = (MODE & 1) != 0;
  constexpr bool SAMPLE = MODE >= 2;
  constexpr int NM = DA ? 2 : 1;
  const int tid = otid512(), lane = tid & 63, w = tid >> 6, r = lane & 31, h = lane >> 5;
  u16* sKV = (u16*)smem;
  constexpr int KVSTG = 64 * 72 + 64 * 68;
  float* sRpb = (float*)(sKV + 2 * KVSTG);
  u16* sQ = (u16*)(sRpb + 512);
  int b, qt, head;
  if (SAMPLE) {
    b = item >> 7;
    qt = (item >> 3) & 15;
    head = item & 7;
  } else {
    b = item >> 3;
    qt = 0;
    head = item & 7;
  }
  const int tokbase = SAMPLE ? NPR + b * 4096 : b * 256;
  const int tq = tokbase + qt * 256 + w * 32 + r;
  const int qcol = (DA ? 1536 : 0) + head * 64;
  u16* urm = (u16*)(p.ws + OFF_URM);
  int nlat, lat_tok0, rlo = 0;
  if (!SAMPLE) {
    nlat = 4;
    lat_tok0 = tokbase;
  } else if (DA) {
    nlat = 64;
    lat_tok0 = tokbase;
  } else {
    int r0a = clampi(4 * qt - 4, 0, 56), r0b = clampi(4 * qt - 1, 0, 56);
    rlo = r0a;
    nlat = r0b + 8 - r0a;
    lat_tok0 = tokbase + rlo * 64;
  }
  int nch = __builtin_amdgcn_readfirstlane(nlat + (SAMPLE ? 4 : 0));
  nlat = __builtin_amdgcn_readfirstlane(nlat);
  asm volatile("" : "+s"(nch));
  asm volatile("" : "+s"(nlat));
  const float LOG2E = 1.4426950408889634f;
  __syncthreads();
  if (MODE == 2) {
    const float* rp = p.na_rpb + ((long)l * 8 + head) * 465;
    for (int i = tid; i < 465; i += 512) sRpb[i] = rp[i] * LOG2E;
  }
#pragma unroll
  for (int i = 0; i < 4; ++i) {
    const int id = tid + 512 * i, row = id >> 3, c8 = (id & 7) * 8;
    *(u32x4*)(sQ + row * 72 + c8) = *(const u32x4*)(urm + (long)(tokbase + qt * 256 + row) * 6144 + qcol + c8);
  }
  const u16* sQw = sQ + (w * 32 + r) * 72 + h * 8;
  const float sc = (DA ? 0.17677669529663687f : 0.125f) * LOG2E;
  float mrun[NM], lsum[NM];
  f32x16 O[NM][2];
#pragma unroll
  for (int mp = 0; mp < NM; ++mp) {
    mrun[mp] = -1e30f;
    lsum[mp] = 0.f;
    O[mp][0] = zero16();
    O[mp][1] = zero16();
  }
  const int qrow = 4 * qt + (w >> 1);
  const int r0q = clampi(qrow - 4, 0, 56);
  const int qc = 32 * (w & 1) + r;
  const int c0 = clampi(qc - 8, 0, 48);

  const int key = tid >> 3, part = tid & 7;
  u32x4 k0;
  unsigned vq[4];
#define ATT_PREFETCH(CK)                                                                            \
  {                                                                                                 \
    const u16* src_ = urm + (long)(lat_tok0 + (CK) * 64 + key) * 6144 + qcol;                       \
    k0 = *(const u32x4*)(src_ + 512 + part * 8);                                                    \
    _Pragma("unroll") for (int m = 0; m < 4; ++m) vq[m] = *(const unsigned*)(src_ + 1024 + 16 * m + 2 * part); \
  }
#define ATT_WRITE(STG, CK)                                                                          \
  {                                                                                                 \
    if ((CK) >= nlat) {                                                                             \
      const int ckey_ = ((CK) - nlat) * 64 + key;                                                   \
      const long off_ = ((((long)b * 4 + l) * 256 + ckey_) * 8 + head) * 64;                        \
      const float* kp_ = (DA ? p.cda_k : p.cna_k) + off_ + part * 8;                                \
      const float* vp_ = (DA ? p.cda_v : p.cna_v) + off_ + 2 * part;                                \
      float4 a0_ = *(const float4*)kp_, a1_ = *(const float4*)(kp_ + 4);                            \
      k0[0] = pk2(a0_.x, a0_.y); k0[1] = pk2(a0_.z, a0_.w); k0[2] = pk2(a1_.x, a1_.y); k0[3] = pk2(a1_.z, a1_.w); \
      _Pragma("unroll") for (int m = 0; m < 4; ++m) {                                               \
        float2 cv_ = *(const float2*)(vp_ + 16 * m);                                                \
        vq[m] = pk2(cv_.x, cv_.y);                                                                  \
      }                                                                                             \
    }                                                                                               \
    u16* sKw_ = sKV + (STG) * KVSTG;                                                                \
    u16* sVw_ = sKw_ + 64 * 72;                                                                     \
    *(u32x4*)(sKw_ + key * 72 + part * 8) = k0;                                                     \
    _Pragma("unroll") for (int m = 0; m < 4; ++m) {                                                 \
      const int dv_ = 16 * m + 2 * part;                                                            \
      sVw_[(dv_ + 0) * 68 + key] = (u16)(vq[m] & 0xffffu);                                          \
      sVw_[(dv_ + 1) * 68 + key] = (u16)(vq[m] >> 16);                                              \
    }                                                                                               \
  }
  ATT_PREFETCH(0)
  ATT_WRITE(0, 0)
  if (1 < nlat) ATT_PREFETCH(1)
  __syncthreads();
#pragma unroll 1
  for (int ck = 0; ck < nch; ++ck) {
    const u16* sK = sKV + (ck & 1) * KVSTG;
    const u16* sVt = sK + 64 * 72;
    const bool latent = ck < nlat;
    const int kr = rlo + ck;
    bool active = true;
    if (MODE == 2 && latent) active = (kr >= r0q) && (kr < r0q + 8);
    if (active) {
#pragma unroll
      for (int mp = 0; mp < NM; ++mp) {
        f32x16 S[2];
        S[0] = zero16();
        S[1] = zero16();
#pragma unroll
        for (int st = 0; st < 2; ++st)
#pragma unroll
          for (int kk = 0; kk < (DA ? 2 : 4); ++kk) {
            const int ks = DA ? (2 * mp + kk) : kk;
            bf16x8 kf = *(const bf16x8*)(sK + (st * 32 + r) * 72 + ks * 16 + h * 8);
            bf16x8 qfr = *(const bf16x8*)(sQw + ks * 16);
            S[st] = mfma32(kf, qfr, S[st]);
          }
        const bool masked = (MODE == 2) && latent;
        float mx = -INFINITY;
        if (masked) {
#pragma unroll
          for (int st = 0; st < 2; ++st)
#pragma unroll
            for (int g = 0; g < 16; ++g) {
              float t = S[st][g] * sc;
              int kc = st * 32 + rowmap(g, h);
              bool ok = (kc >= c0) && (kc < c0 + 16);
              int dc = clampi(kc - qc, -15, 15);
              float bias = sRpb[(kr - qrow + 7) * 31 + dc + 15];
              t = ok ? t + bias : -INFINITY;
              S[st][g] = t;
              mx = fmaxf(mx, t);
            }
          mx = fmaxf(mx, shx(mx, lane, 32));
        } else {
#pragma unroll
          for (int st = 0; st < 2; ++st)
#pragma unroll
            for (int g = 0; g < 16; ++g) mx = fmaxf(mx, S[st][g]);
          mx = fmaxf(mx, shx(mx, lane, 32)) * sc;
        }
        const float mold = mrun[mp];
        const bool upd = mx > mold + 8.f;
        const float mnew = upd ? mx : mold;
        if (__builtin_amdgcn_ballot_w64(upd) != 0ull) {
          const float alpha = __builtin_amdgcn_exp2f(mold - mnew);
          mrun[mp] = mnew;
          lsum[mp] *= alpha;
#pragma unroll
          for (int g = 0; g < 16; ++g) {
            O[mp][0][g] *= alpha;
            O[mp][1][g] *= alpha;
          }
        }
        float ps = 0.f;
        if (masked) {
#pragma unroll
          for (int st = 0; st < 2; ++st)
#pragma unroll
            for (int g = 0; g < 16; ++g) {
              float pv = __builtin_amdgcn_exp2f(S[st][g] - mnew);
              S[st][g] = pv;
              ps += pv;
            }
        } else {
#pragma unroll
          for (int st = 0; st < 2; ++st)
#pragma unroll
            for (int g = 0; g < 16; ++g) {
              float pv = __builtin_amdgcn_exp2f(__builtin_fmaf(S[st][g], sc, -mnew));
              S[st][g] = pv;
              ps += pv;
            }
        }
        lsum[mp] += ps;
#pragma unroll
        for (int st = 0; st < 2; ++st)
#pragma unroll
          for (int s2 = 0; s2 < 2; ++s2) {
            u32x4 pu;
#pragma unroll
            for (int e = 0; e < 4; ++e) pu[e] = pk2(S[st][8 * s2 + 2 * e], S[st][8 * s2 + 2 * e + 1]);
            const bf16x8 pf = (bf16x8)pu;
#pragma unroll
            for (int dvt = 0; dvt < 2; ++dvt) {
              const u16* vp = sVt + (dvt * 32 + r) * 68 + st * 32 + s2 * 16 + 4 * h;
              u32x2 lo = *(const u32x2*)vp;
              u32x2 hi = *(const u32x2*)(vp + 8);
              u32x4 vv;
              vv[0] = lo[0]; vv[1] = lo[1]; vv[2] = hi[0]; vv[3] = hi[1];
              O[mp][dvt] = mfma32((bf16x8)vv, pf, O[mp][dvt]);
            }
          }
      }
    }
    if (ck + 1 < nch) ATT_WRITE((ck + 1) & 1, ck + 1)
    if (ck + 2 < nlat) ATT_PREFETCH(ck + 2)
    __syncthreads();
  }
#undef ATT_WRITE
#undef ATT_PREFETCH
  float inv[NM];
#pragma unroll
  for (int mp = 0; mp < NM; ++mp) {
    float lt = lsum[mp] + shx(lsum[mp], lane, 32);
    inv[mp] = 1.f / lt;
  }
  u16* dst = urm + (long)tq * 6144 + qcol;
  if (!DA) {
#pragma unroll
    for (int dvt = 0; dvt < 2; ++dvt)
#pragma unroll
      for (int g4 = 0; g4 < 4; ++g4) {
        u32x2 o2;
        o2[0] = pk2(O[0][dvt][4 * g4] * inv[0], O[0][dvt][4 * g4 + 1] * inv[0]);
        o2[1] = pk2(O[0][dvt][4 * g4 + 2] * inv[0], O[0][dvt][4 * g4 + 3] * inv[0]);
        *(u32x2*)(dst + dvt * 32 + 8 * g4 + 4 * h) = o2;
      }
  } else {
    const float lam = ((const float*)(p.ws + OFF_LAM))[l];
    const float one_m_li = ((const float*)(p.ws + OFF_LAM))[4 + l];
    float ss = 0.f;
#pragma unroll
    for (int dvt = 0; dvt < 2; ++dvt)
#pragma unroll
      for (int g = 0; g < 16; ++g) {
        float o = O[0][dvt][g] * inv[0] - lam * (O[NM - 1][dvt][g] * inv[NM - 1]);
        O[0][dvt][g] = o;
        ss += o * o;
      }
    ss += shx(ss, lane, 32);
    const float rn = rsqrtf(ss * (1.f / 64.f) + 1e-6f) * one_m_li;
    const float* sg = p.da_subln + l * 64;
#pragma unroll
    for (int dvt = 0; dvt < 2; ++dvt)
#pragma unroll
      for (int g4 = 0; g4 < 4; ++g4) {
        const int dv = dvt * 32 + 8 * g4 + 4 * h;
        float4 gg = *(const float4*)(sg + dv);
        u32x2 o2;
        o2[0] = pk2(O[0][dvt][4 * g4] * rn * gg.x, O[0][dvt][4 * g4 + 1] * rn * gg.y);
        o2[1] = pk2(O[0][dvt][4 * g4 + 2] * rn * gg.z, O[0][dvt][4 * g4 + 3] * rn * gg.w);
        *(u32x2*)(dst + dv) = o2;
      }
  }
}


#define XB_TMO      128
#define XB_XCNT(j)  (256  + 64 * (j))
#define XB_XSUB(j)  (1280 + 64 * (j))
#define XB_XGEN(j)  (2304 + 64 * (j))
#define XB_TOP      3328
#define XB_TOPGEN   3392
#define XCD_BAR_WORDS 3456
#define XB_SPIN_CAP (1u << 22)
__device__ __forceinline__ unsigned xb_ld(unsigned* p) { return __hip_atomic_load(p, __ATOMIC_RELAXED, __HIP_MEMORY_SCOPE_AGENT); }
__device__ __forceinline__ unsigned xb_add(unsigned* p, unsigned v) { return __hip_atomic_fetch_add(p, v, __ATOMIC_RELAXED, __HIP_MEMORY_SCOPE_AGENT); }
__device__ __forceinline__ unsigned xb_xcc_id() { return (unsigned)__builtin_amdgcn_s_getreg((3 << 11) | 20) & 0xFu; }
#define XB_SPIN(cond, bar) do { unsigned _sp = 0; while (cond) { __builtin_amdgcn_s_sleep(1); \
    if ((++_sp & 255u) == 0u) { if (xb_ld(&(bar)[XB_TMO])) break; if (_sp > XB_SPIN_CAP) { atomicAdd(&(bar)[XB_TMO], 1u); break; } } } } while (0)
struct XcdBarrier { unsigned* bar; unsigned x; volatile LAS unsigned* st; };
__device__ __forceinline__ XcdBarrier xcd_barrier_post(unsigned* bar, volatile LAS unsigned* st) {
  XcdBarrier b; b.bar = bar; b.x = xb_xcc_id(); b.st = st;
  if (threadIdx.x == 0) (void)xb_add(&bar[XB_XCNT(b.x)], 1u);
  return b;
}
__device__ __forceinline__ void xcd_barrier_complete(unsigned* bar, unsigned x, unsigned& nloc, unsigned& nx) {
  const unsigned G = gridDim.x * gridDim.y * gridDim.z;
  unsigned sum, cnt, mine, sp = 0u;
  for (;;) {
    sum = 0u; cnt = 0u; mine = 0u;
#pragma unroll
    for (unsigned j = 0; j < 16; ++j) { const unsigned c = xb_ld(&bar[XB_XCNT(j)]); sum += c; cnt += (c > 0u) ? 1u : 0u; mine = (j == x) ? c : mine; }
    if (sum == G) break;
    __builtin_amdgcn_s_sleep(1);
    if ((++sp & 255u) == 0u) { if (xb_ld(&bar[XB_TMO])) break; if (sp > XB_SPIN_CAP) { atomicAdd(&bar[XB_TMO], 1u); break; } }
  }
  nloc = mine > 0u ? mine : 1u; nx = cnt > 0u ? cnt : 1u;
}
__device__ __forceinline__ void xcd_barrier(const XcdBarrier& b) {
  asm volatile("s_waitcnt vmcnt(0)" ::: "memory");
  __syncthreads();
  if (threadIdx.x == 0) {
    unsigned* bar = b.bar;
    __builtin_amdgcn_s_waitcnt(0);
    unsigned nloc = b.st[0], nx = b.st[1];
    if (nloc == 0u) { xcd_barrier_complete(bar, b.x, nloc, nx); b.st[0] = nloc; b.st[1] = nx; }
    const unsigned old = xb_add(&bar[XB_XSUB(b.x)], 1u);
    const unsigned gen = old / nloc;
    if (old + 1u == (gen + 1u) * nloc) {
      __builtin_amdgcn_fence(__ATOMIC_RELEASE, "agent");
      asm volatile("s_waitcnt vmcnt(0)" ::: "memory");
      const unsigned og = xb_add(&bar[XB_TOP], 1u);
      const unsigned tg = og / nx;
      if (og + 1u == (tg + 1u) * nx) xb_add(&bar[XB_TOPGEN], 1u);
      else XB_SPIN(xb_ld(&bar[XB_TOPGEN]) == tg, bar);
      __builtin_amdgcn_fence(__ATOMIC_ACQUIRE, "agent");
      xb_add(&bar[XB_XGEN(b.x)], 1u);
      asm volatile("s_waitcnt vmcnt(0)" ::: "memory");
    } else {
      XB_SPIN(xb_ld(&bar[XB_XGEN(b.x)]) == gen, bar);
      __builtin_amdgcn_fence(__ATOMIC_ACQUIRE, "agent");
      asm volatile("s_waitcnt vmcnt(0)" ::: "memory");
    }
  }
  __syncthreads();
}

__global__ void __launch_bounds__(512, 2) trunk_megakernel(Params p) {
  __shared__ __attribute__((aligned(16))) char smem[SMEM_BYTES];
  __shared__ uint4 xb_words;
  cg::grid_group grid = cg::this_grid();
  const int nb = gridDim.x, bid = blockIdx.x;
  const int half = __builtin_amdgcn_readfirstlane((int)(threadIdx.x >> 8));
  char* hsm = smem + half * HALF_BYTES;
  LAS char* lsm = (LAS char*)smem;
  if (threadIdx.x == 0) xb_words = make_uint4(0u, 0u, 0u, 0u);
  __syncthreads();
  XcdBarrier xb = xcd_barrier_post((unsigned*)(p.ws + OFF_BAR), (volatile LAS unsigned*)&xb_words);

  for (int it = bid; it < 385; it += nb) phase0_item(p, 2 * it + half, hsm);
  grid.sync();

  for (int l = 0; l < 4; ++l) {
    for (int it = bid; it < 544; it += nb) {
      const int item = 2 * it + half;
      filter_item(p, l, item >> 3, item & 7, hsm);
    }
    if (nb == 256) {
      const int q0 = (bid >= 32) ? (bid - 32) : (3712 + bid);
      const int qs = (bid >= 32) ? 224 : 32;
      const int qe = (bid >= 32) ? 3712 : 3872;
      for (int q = q0; q < qe; q += qs) {
        const int item = 2 * q + half;
        if (item < 4672) convert_item(p, l, item, hsm);
        else norm_item(p, l, 0, item - 4672);
      }
    } else {
      for (int q = bid; q < 3872; q += nb) {
        const int item = 2 * q + half;
        if (item < 4672) convert_item(p, l, item, hsm);
        else norm_item(p, l, 0, item - 4672);
      }
    }
    xcd_barrier(xb);
    for (int it = bid; it < 96 * 30; it += nb) gemm_in_fast(p, l, it, lsm);
    xcd_barrier(xb);
    for (int it = bid; it < 256 + 512 + 512 + 256 + 256 + 256; it += nb) {
      if (it < 256) hyena_item<64>(p, l, 2 * it + half, hsm);
      else if (it < 768) attn_item<3>(p, l, it - 256, smem);
      else if (it < 1280) attn_item<2>(p, l, it - 768, smem);
      else if (it < 1536) attn_item<0>(p, l, it - 1280, smem);
      else if (it < 1792) attn_item<1>(p, l, it - 1536, smem);
      else hyena_item<4>(p, l, 2 * (it - 1792) + half, hsm);
    }
    xcd_barrier(xb);
    for (int it = bid; it < 192 * 8; it += nb) lift_pair_item(p, l, it, smem);
    xcd_barrier(xb);
    for (int it = bid; it < 96 * 4; it += nb) resid_fast(p, l, 0, it, lsm);
    xcd_barrier(xb);
    for (int it = bid; it < 1536; it += nb) norm_item(p, l, 1, 2 * it + half);
    xcd_barrier(xb);
    for (int it = bid; it < 96 * 22; it += nb) ffn_in_fast(p, l, it, lsm);
    xcd_barrier(xb);
    for (int it = bid; it < 96 * 4; it += nb) resid_fast(p, l, 1, it, lsm);
    xcd_barrier(xb);
  }
  for (int it = bid; it < 3072; it += nb) final_norm_item(p, 2 * it + half);
}

extern "C" void kernel_launch(void* const* d_in, const int* in_sizes, int n_in, void* d_out, int out_size, void* d_ws,
                              size_t ws_size, hipStream_t stream) {
  static int grid_blocks = 0;
  if (!grid_blocks) {
    int dev = 0, cus = 0, per_cu = 0;
    hipGetDevice(&dev);
    hipDeviceGetAttribute(&cus, hipDeviceAttributeMultiprocessorCount, dev);
    hipOccupancyMaxActiveBlocksPerMultiprocessor(&per_cu, trunk_megakernel, 512, 0);
    if (per_cu > 1) per_cu = 1;
    if (per_cu < 1) per_cu = 1;
    grid_blocks = cus * per_cu;
  }
  Params p{};
  const float** pp = (const float**)&p;
  for (int i = 0; i < 30; ++i) pp[i] = (const float*)d_in[i];
  p.out = (float*)d_out;
  p.ws = (char*)d_ws;
  if (ws_size < (size_t)WS_NEED) fprintf(stderr, "workspace too small: %zu < %ld\n", ws_size, (long)WS_NEED);
  hipMemsetAsync((char*)d_ws + OFF_BAR, 0, XCD_BAR_WORDS * 4, stream);
  void* args[] = {&p};
  hipError_t e = hipLaunchCooperativeKernel((void*)trunk_megakernel, dim3(grid_blocks), dim3(512), args, 0, stream);
  if (e != hipSuccess) fprintf(stderr, "cooperative launch failed: %s (grid %d)\n", hipGetErrorString(e), grid_blocks);
}
```
